# Optimizing an MI355X kernel written in HIP

```python
import jax
import jax.numpy as jnp
from jax import lax
import numpy as np

D_MODEL = 1024
BATCH = 8
SEQ = 2048
DEPTH = 1

CTX_LEN = 256
GRID_W = 64
FOURIER_W = 512
FOURIER_GROUPS = 8
RWKV_W = D_MODEL - FOURIER_W
HEAD = 64
N_HEADS = RWKV_W // HEAD
N_DIR = 2
DECAY_RANK = 64
ICLR_RANK = 64
GATE_RANK = 128
D_FF = 2816
RWKV_PROJ_W = 3 * RWKV_W + N_DIR * DECAY_RANK + N_DIR * ICLR_RANK + GATE_RANK
PROJ_W = FOURIER_W + RWKV_PROJ_W
NORM_EPS = 1e-6
GN_EPS = 64e-5
KK_EPS = 1e-12

kernel_name = "hybrid_fourier_rwkv7_convffn_prefix"


def rms_norm(x, g):
    xf = x.astype(jnp.float32)
    y = xf * lax.rsqrt(jnp.mean(xf * xf, axis=-1, keepdims=True) + NORM_EPS)
    return (y * g.astype(jnp.float32)).astype(x.dtype)


def modulate(h, shift, scale):
    return h * (1 + scale) + shift


def conv1d_centred(u, w):
    up = jnp.pad(u, ((0, 0), (1, 1), (0, 0)))
    return up[:, :-2] * w[0] + up[:, 1:-1] * w[1] + up[:, 2:] * w[2]


def conv2d_grid(u, w, rows):
    b, t, ch = u.shape
    g = u.reshape(b, rows, GRID_W, ch)
    y = lax.conv_general_dilated(g, w[:, :, None, :].astype(u.dtype), (1, 1), "SAME",
                                 dimension_numbers=("NHWC", "HWIO", "NHWC"),
                                 feature_group_count=ch)
    return y.reshape(b, t, ch)


def fourier_mix(u, g):
    b, t, _ = u.shape
    uf = u.astype(jnp.float32).reshape(b, t, FOURIER_GROUPS, FOURIER_W // FOURIER_GROUPS)
    y = jnp.fft.fft2(uf, axes=(1, 3), norm="ortho").real
    return rms_norm(y.reshape(b, t, FOURIER_W), g).astype(u.dtype)


def rwkv_inputs(u, conv_w, w0, w2, a0, a2, k_k, k_a):
    b, t, _ = u.shape
    rkv = conv1d_centred(u[..., :3 * RWKV_W], conv_w)
    r, k, v = jnp.split(rkv, 3, axis=-1)
    o = 3 * RWKV_W
    wd = u[..., o:o + N_DIR * DECAY_RANK].reshape(b, t, N_DIR, DECAY_RANK)
    o += N_DIR * DECAY_RANK
    ad = u[..., o:o + N_DIR * ICLR_RANK].reshape(b, t, N_DIR, ICLR_RANK)
    o += N_DIR * ICLR_RANK
    gd = u[..., o:]
    w_lora = (w0 + jnp.einsum("btdr,drc->btdc", jnp.tanh(wd), w2)).astype(jnp.float32)
    decay = jnp.exp(-jnp.exp(-jax.nn.softplus(-w_lora) - 0.5))
    a = jax.nn.sigmoid((a0 + jnp.einsum("btdr,drc->btdc", ad, a2)).astype(jnp.float32))
    kk = (k * k_k).astype(jnp.float32).reshape(b, t, N_HEADS, HEAD)
    kk = kk * lax.rsqrt(jnp.sum(kk * kk, axis=-1, keepdims=True) + KK_EPS)
    kk = kk.reshape(b, t, RWKV_W)
    kd = k.astype(jnp.float32)[:, :, None] * (1 + (a - 1) * k_a)
    return r, kd, v, kk, a, decay, gd


def _heads_time_major(x2):
    d, b, t, _ = x2.shape
    return x2.astype(jnp.float32).reshape(d, b, t, N_HEADS, HEAD).transpose(2, 0, 1, 3, 4)


def shared_dirs(x):
    return _heads_time_major(jnp.stack([x, jnp.flip(x, axis=1)], axis=0))


def per_dir(x):
    return _heads_time_major(jnp.stack([x[:, :, 0], jnp.flip(x[:, :, 1], axis=1)], axis=0))


def merge_dirs(y):
    y = y.transpose(1, 2, 0, 3, 4)
    return y[0] + jnp.flip(y[1], axis=1)


def rwkv_scan(prep, state0, readout):
    r, kd, v, kk, a, decay, _ = prep
    xs = (shared_dirs(r), per_dir(kd), shared_dirs(v), shared_dirs(kk), per_dir(a), per_dir(decay))

    def step(s, inp):
        r_t, k_t, v_t, kk_t, a_t, w_t = inp
        sa = jnp.einsum("dbhij,dbhj->dbhi", s, kk_t)
        s = (s * w_t[..., None, :] - sa[..., :, None] * (kk_t * a_t)[..., None, :]
             + v_t[..., :, None] * k_t[..., None, :])
        y = jnp.einsum("dbhij,dbhj->dbhi", s, r_t) if readout else None
        return s, y

    return lax.scan(step, state0, xs)


def rwkv_output(y, prep, g2, r_k, gn_g, gn_b):
    r, kd, v, _, _, _, gd = prep
    b, t = r.shape[:2]
    mu = jnp.mean(y, axis=-1, keepdims=True)
    var = jnp.mean(jnp.square(y - mu), axis=-1, keepdims=True)
    yn = ((y - mu) * lax.rsqrt(var + GN_EPS)).reshape(b, t, RWKV_W)
    yn = yn * gn_g.astype(jnp.float32) + gn_b.astype(jnp.float32)
    rh = r.astype(jnp.float32).reshape(b, t, N_HEADS, HEAD)
    vh = v.astype(jnp.float32).reshape(b, t, N_HEADS, HEAD)
    kdh = kd.reshape(b, t, N_DIR, N_HEADS, HEAD)
    bonus = jnp.einsum("bthn,btdhn,hn->bth", rh, kdh, r_k.astype(jnp.float32))[..., None] * vh
    gate = jax.nn.sigmoid(gd.astype(jnp.float32)) @ g2.astype(jnp.float32)
    return (yn + bonus.reshape(b, t, RWKV_W)) * gate


def token_mixer(h, hc, w_in, conv_w, w0, w2, a0, a2, g2, k_k, k_a, r_k, gn_g, gn_b,
                f_g, w_out, ctx_out):
    u = h @ w_in
    uc = hc @ (w_in if ctx_out else w_in[:, FOURIER_W:])
    uc_r = uc[..., FOURIER_W:] if ctx_out else uc
    prep_l = rwkv_inputs(u[..., FOURIER_W:], conv_w, w0, w2, a0, a2, k_k, k_a)
    prep_c = rwkv_inputs(uc_r, conv_w, w0, w2, a0, a2, k_k, k_a)
    state0 = jnp.zeros((N_DIR, hc.shape[0], N_HEADS, HEAD, HEAD), jnp.float32)
    state_c, y_c = rwkv_scan(prep_c, state0, ctx_out)
    _, y_l = rwkv_scan(prep_l, state_c, True)
    rw_l = rwkv_output(merge_dirs(y_l), prep_l, g2, r_k, gn_g, gn_b).astype(h.dtype)
    out = jnp.concatenate([fourier_mix(u[..., :FOURIER_W], f_g).astype(h.dtype), rw_l], axis=-1) @ w_out
    out_c = None
    if ctx_out:
        rw_c = rwkv_output(merge_dirs(y_c), prep_c, g2, r_k, gn_g, gn_b).astype(hc.dtype)
        out_c = jnp.concatenate([fourier_mix(uc[..., :FOURIER_W], f_g).astype(hc.dtype), rw_c], axis=-1) @ w_out
    return out, out_c


def conv_ffn(h, w_up, conv_w, conv_b, w_down, rows):
    u = h @ w_up
    if rows is None:
        u = conv1d_centred(u, conv_w[1]) + conv_b
    else:
        u = conv2d_grid(u, conv_w, rows) + conv_b
    gate, val = jnp.split(u, 2, axis=-1)
    return (jax.nn.silu(gate) * val) @ w_down


def setup_inputs(seed: int = 0) -> dict:
    key = jax.random.key(seed)
    ks = jax.random.split(key, 27)
    L, D, C, F2 = DEPTH, D_MODEL, RWKV_W, 2 * D_FF

    def nrm(i, shape, s=1.0):
        return s * jax.random.normal(ks[i], shape, jnp.float32)

    def near_one(i, shape):
        return 1.0 + nrm(i, shape, 0.05)

    centre3 = jnp.zeros((3,), jnp.float32).at[1].set(1.0)
    centre33 = jnp.zeros((3, 3), jnp.float32).at[1, 1].set(1.0)
    return {
        "x": nrm(0, (BATCH, SEQ, D)),
        "c": nrm(1, (BATCH, D)),
        "ctx": nrm(2, (BATCH, CTX_LEN, D)),
        "c_ctx": nrm(3, (D,)),
        "ada_w": nrm(4, (L, D, 6 * D), 0.5 * D ** -0.5),
        "ada_b": nrm(5, (L, 6 * D), 0.02),
        "norm1_g": near_one(6, (L, D)),
        "norm2_g": near_one(7, (L, D)),
        "w_in": nrm(8, (L, D, PROJ_W), D ** -0.5),
        "rwkv_conv_w": centre3[None, :, None] + nrm(9, (L, 3, 3 * C), 0.1),
        "decay_w0": -1.0 + nrm(10, (L, N_DIR, C), 1.5),
        "decay_w2": nrm(11, (L, N_DIR, DECAY_RANK, C), 0.1 * DECAY_RANK ** -0.5),
        "iclr_a0": nrm(12, (L, N_DIR, C), 0.5),
        "iclr_a2": nrm(13, (L, N_DIR, ICLR_RANK, C), 0.1 * ICLR_RANK ** -0.5),
        "gate_g2": nrm(14, (L, GATE_RANK, C), GATE_RANK ** -0.5),
        "k_k": 0.85 + nrm(15, (L, C), 0.05),
        "k_a": near_one(16, (L, C)),
        "r_k": nrm(17, (L, N_HEADS, HEAD), 0.1),
        "gn_g": near_one(18, (L, C)),
        "gn_b": nrm(19, (L, C), 0.02),
        "fourier_g": near_one(20, (L, FOURIER_W)),
        "w_out": nrm(21, (L, D, D), D ** -0.5),
        "ffn_w_up": nrm(22, (L, D, F2), D ** -0.5),
        "ffn_conv_w": centre33[None, :, :, None] + nrm(23, (L, 3, 3, F2), 0.1),
        "ffn_conv_b": nrm(24, (L, F2), 0.02),
        "ffn_w_down": nrm(25, (L, D_FF, D), D_FF ** -0.5),
        "final_g": near_one(26, (D,)),
    }


def reference(x, c, ctx, c_ctx, ada_w, ada_b, norm1_g, norm2_g, w_in, rwkv_conv_w,
              decay_w0, decay_w2, iclr_a0, iclr_a2, gate_g2, k_k, k_a, r_k, gn_g, gn_b,
              fourier_g, w_out, ffn_w_up, ffn_conv_w, ffn_conv_b, ffn_w_down, final_g):
    rows = x.shape[1] // GRID_W
    for l in range(DEPTH):
        last = l == DEPTH - 1
        mod_x = jax.nn.silu(c) @ ada_w[l] + ada_b[l]
        mod_c = jax.nn.silu(c_ctx) @ ada_w[l] + ada_b[l]
        sh1, sc1, g1, sh2, sc2, g2 = [m[:, None, :] for m in jnp.split(mod_x, 6, axis=-1)]
        sh1c, sc1c, g1c, sh2c, sc2c, g2c = jnp.split(mod_c, 6, axis=-1)

        h = modulate(rms_norm(x, norm1_g[l]), sh1, sc1)
        hc = modulate(rms_norm(ctx, norm1_g[l]), sh1c, sc1c)
        y, yc = token_mixer(h, hc, w_in[l], rwkv_conv_w[l], decay_w0[l], decay_w2[l],
                            iclr_a0[l], iclr_a2[l], gate_g2[l], k_k[l], k_a[l], r_k[l],
                            gn_g[l], gn_b[l], fourier_g[l], w_out[l], not last)
        x = x + g1 * y
        h = modulate(rms_norm(x, norm2_g[l]), sh2, sc2)
        x = x + g2 * conv_ffn(h, ffn_w_up[l], ffn_conv_w[l], ffn_conv_b[l], ffn_w_down[l], rows)
        if not last:
            ctx = ctx + g1c * yc
            hc = modulate(rms_norm(ctx, norm2_g[l]), sh2c, sc2c)
            ctx = ctx + g2c * conv_ffn(hc, ffn_w_up[l], ffn_conv_w[l], ffn_conv_b[l],
                                       ffn_w_down[l], None)
    return rms_norm(x, final_g)
```

```cpp
#include <hip/hip_runtime.h>
#include <cstdio>
#include <cstdint>
#ifndef PROBE_DUP
#define PROBE_DUP 0
#endif
#ifndef PROBE_VAR
#define PROBE_VAR 0
#endif
#define REPS(k) for (int rep_ = 0; rep_ < ((PROBE_DUP == (k)) ? 2 : 1); ++rep_)

namespace pg8 {
#define PG8_LAS __attribute__((address_space(3)))
typedef unsigned short bf16_t;
typedef short bf16x8 __attribute__((ext_vector_type(8)));
typedef float f32x4 __attribute__((ext_vector_type(4)));
typedef unsigned u32x4 __attribute__((ext_vector_type(4)));
constexpr int BM = 256, BK = 64, HALF = 128, HTB = HALF * BK * 2, STAGE_BYTES = 8 * HTB, NXCD = 8, WGM = 8;

__host__ __device__ __forceinline__ int lds_byte(int r, int c) { const int st = (r >> 4) * 2 + (c >> 5), rr = r & 15, cc = c & 31, ob = rr * 64 + cc * 2; return st * 1024 + (ob ^ (((ob >> 9) & 1) << 5)); }
__host__ __device__ __forceinline__ void stage_rc(int b, int& R, int& C) { const int st = b / 1024, sb = b % 1024, swz = sb ^ (((sb >> 9) & 1) << 5); R = (st >> 1) * 16 + swz / 64; C = (st & 1) * 32 + (swz % 64) / 2; }
__host__ __device__ __forceinline__ int perm32(int rho) { const int n = rho >> 4, i = rho & 15; return 8 * (i >> 2) + 4 * n + (i & 3); }

struct Unit { int pm, pn, aux; };
struct Gemm { const bf16_t* A; const bf16_t* Bt; int M, N, K, lda, ldb; int ksplit; long adelta; };

struct StaticOrder {
    int nM, nN, nwg, G, c;
    __host__ __device__ void init(int M, int N, int G_, int c_) { nM = M / BM; nN = N / BM; nwg = nM * nN; G = G_; c = c_; }
    __host__ __device__ bool next(int i, Unit& u) const {
        const long L = (long)i * G + c; if (L >= nwg) return false;
        int wgid = (int)L; { const int q = nwg / NXCD, r = nwg % NXCD, xcd = wgid % NXCD, off = wgid / NXCD; wgid = (xcd < r ? xcd * (q + 1) : r * (q + 1) + (xcd - r) * q) + off; }
        const int nig = WGM * nN, gid = wgid / nig, fm = gid * WGM, gsz = (nM - fm) < WGM ? (nM - fm) : WGM;
        u.pm = fm + ((wgid % nig) % gsz); u.pn = (wgid % nig) / gsz; u.aux = 0; return true;
    }
    __device__ __forceinline__ const char* aptr(const Gemm& g, const Unit& u) const { return (const char*)g.A + (size_t)u.pm * BM * g.lda * 2; }
    __device__ __forceinline__ const char* bptr(const Gemm& g, const Unit& u) const { return (const char*)g.Bt + (size_t)u.pn * BM * g.ldb * 2; }
    __device__ __forceinline__ void a_ready(const Unit&) const {}
    __device__ __forceinline__ void done(const Unit&) const {}
};
struct DftOrder {
    int G, c;
    __device__ bool next(int i, Unit& u) const { const int L = i * G + c; if (L >= 256) return false; u.aux = L >> 7; const int r = L & 127; u.pn = r & 15; u.pm = r >> 4; return true; }
    __device__ __forceinline__ const char* aptr(const Gemm& g, const Unit& u) const { return (const char*)g.A + ((size_t)u.pm * BM * g.lda + (size_t)u.aux * 1024) * 2; }
    __device__ __forceinline__ const char* bptr(const Gemm& g, const Unit& u) const { return (const char*)g.Bt + ((size_t)u.pn * BM * g.ldb + (u.pm >= 4 ? 2048 : 0) + (size_t)u.aux * 1024) * 2; }
    __device__ __forceinline__ void a_ready(const Unit&) const {}
    __device__ __forceinline__ void done(const Unit&) const {}
};

typedef __bf16 bf2_t __attribute__((ext_vector_type(2)));
typedef float f2_t __attribute__((ext_vector_type(2)));
__device__ __forceinline__ unsigned cvt_pk_bf16(float lo, float hi) { const f2_t f = {lo, hi}; const bf2_t b = __builtin_convertvector(f, bf2_t); return __builtin_bit_cast(unsigned, b); }

struct EpiBf16 {
    static constexpr bool PERM = true, AFTER_DRAIN = false;
    bf16_t* O; int ldc; bool skip;
    __device__ __forceinline__ void operator()(const f32x4 (&acc)[2][2][4][2], const Unit& u, int wr, int wc, int fr, int fq) const {
        const int row0 = u.pm * BM + wr * 64 + fr; const int col0 = u.pn * BM + wc * 32 + 8 * fq;
        if (skip) { if (acc[0][0][0][0][0] == 12345.678f) O[0] = 1; return; }
#pragma unroll
        for (int ai = 0; ai < 2; ++ai)
#pragma unroll
            for (int m = 0; m < 4; ++m) { bf16_t* rowp = O + (size_t)(row0 + ai * HALF + m * 16) * ldc + col0;
#pragma unroll
                for (int bj = 0; bj < 2; ++bj) { const f32x4 v0 = acc[ai][bj][m][0], v1 = acc[ai][bj][m][1];
                    u32x4 w; w.x = cvt_pk_bf16(v0[0], v0[1]); w.y = cvt_pk_bf16(v0[2], v0[3]); w.z = cvt_pk_bf16(v1[0], v1[1]); w.w = cvt_pk_bf16(v1[2], v1[3]);
                    *(u32x4*)(rowp + bj * HALF) = w; } }
    }
};
struct EpiU {
    static constexpr bool PERM = true, AFTER_DRAIN = false;
    bf16_t* Uf; bf16_t* Ur;
    __device__ __forceinline__ void operator()(const f32x4 (&acc)[2][2][4][2], const Unit& u, int wr, int wc, int fr, int fq) const {
        bf16_t* base; int ldc, colt;
        if (u.pn < 2) { if (u.pm >= 64) return; base = Uf; ldc = 512; colt = u.pn * BM; } else { base = Ur; ldc = 2048; colt = (u.pn - 2) * BM; }
        const int row0 = u.pm * BM + wr * 64 + fr; const int col0 = colt + wc * 32 + 8 * fq;
#pragma unroll
        for (int ai = 0; ai < 2; ++ai)
#pragma unroll
            for (int m = 0; m < 4; ++m) { bf16_t* rowp = base + (size_t)(row0 + ai * HALF + m * 16) * ldc + col0;
#pragma unroll
                for (int bj = 0; bj < 2; ++bj) { const f32x4 v0 = acc[ai][bj][m][0], v1 = acc[ai][bj][m][1];
                    u32x4 w; w.x = cvt_pk_bf16(v0[0], v0[1]); w.y = cvt_pk_bf16(v0[2], v0[3]); w.z = cvt_pk_bf16(v1[0], v1[1]); w.w = cvt_pk_bf16(v1[2], v1[3]);
                    *(u32x4*)(rowp + bj * HALF) = w; } }
    }
};
struct EpiYpart {
    static constexpr bool PERM = true, AFTER_DRAIN = false;
    bf16_t* O;
    __device__ __forceinline__ void operator()(const f32x4 (&acc)[2][2][4][2], const Unit& u, int wr, int wc, int fr, int fq) const {
        const int row0 = u.pm * BM + wr * 64 + fr; const int col0 = u.pn * BM + wc * 32 + 8 * fq; bf16_t* base = O + (size_t)u.aux * 2048 * 4096;
#pragma unroll
        for (int ai = 0; ai < 2; ++ai)
#pragma unroll
            for (int m = 0; m < 4; ++m) { bf16_t* rowp = base + (size_t)(row0 + ai * HALF + m * 16) * 4096 + col0;
#pragma unroll
                for (int bj = 0; bj < 2; ++bj) { const f32x4 v0 = acc[ai][bj][m][0], v1 = acc[ai][bj][m][1];
                    u32x4 w; w.x = cvt_pk_bf16(v0[0], v0[1]); w.y = cvt_pk_bf16(v0[2], v0[3]); w.z = cvt_pk_bf16(v1[0], v1[1]); w.w = cvt_pk_bf16(v1[2], v1[3]);
                    *(u32x4*)(rowp + bj * HALF) = w; } }
    }
};
struct EpiF32 {
    static constexpr bool PERM = false, AFTER_DRAIN = false;
    float* C; int ldc;
    __device__ __forceinline__ void operator()(const f32x4 (&acc)[2][2][4][2], const Unit& u, int wr, int wc, int fr, int fq) const {
        const int row0 = u.pm * BM + wr * 64 + fr, col0 = u.pn * BM + wc * 32 + 4 * fq;
#pragma unroll
        for (int ai = 0; ai < 2; ++ai)
#pragma unroll
            for (int m = 0; m < 4; ++m) { float* rowp = C + (size_t)(row0 + ai * HALF + m * 16) * ldc + col0;
#pragma unroll
                for (int bj = 0; bj < 2; ++bj)
#pragma unroll
                    for (int n = 0; n < 2; ++n) *(f32x4*)(rowp + bj * HALF + n * 16) = acc[ai][bj][m][n]; }
    }
};
struct EpiResid {
    static constexpr bool PERM = false, AFTER_DRAIN = false;
    const float* base; float* out; int ldc; const float* modb; const float* adab;
    __device__ __forceinline__ void operator()(const f32x4 (&acc)[2][2][4][2], const Unit& u, int wr, int wc, int fr, int fq) const {
        const int row0 = u.pm * BM + wr * 64 + fr, col0 = u.pn * BM + wc * 32 + 4 * fq;
        const int b = (u.pm * BM) >> 11;
        f32x4 gv[2][2];
#pragma unroll
        for (int bj = 0; bj < 2; ++bj)
#pragma unroll
            for (int n = 0; n < 2; ++n) gv[bj][n] = *(const f32x4*)(modb + (size_t)b * 6144 + col0 + bj * HALF + n * 16) + *(const f32x4*)(adab + col0 + bj * HALF + n * 16);
#pragma unroll
        for (int ai = 0; ai < 2; ++ai)
#pragma unroll
            for (int m = 0; m < 4; ++m) { const size_t off = (size_t)(row0 + ai * HALF + m * 16) * ldc + col0;
#pragma unroll
                for (int bj = 0; bj < 2; ++bj)
#pragma unroll
                    for (int n = 0; n < 2; ++n) { const f32x4 bs = *(const f32x4*)(base + off + bj * HALF + n * 16);
                        *(f32x4*)(out + off + bj * HALF + n * 16) = bs + gv[bj][n] * acc[ai][bj][m][n]; } }
    }
};


struct RowSumSq {
    unsigned* xbuf;
    unsigned* cnt;
    __device__ __forceinline__ void run(const f32x4 (&v)[2][2][4][2], const Unit& u, int wr, int wc, int fr, int fq, PG8_LAS unsigned char* lds, int wid, int lane) const {
        PG8_LAS float* P = (PG8_LAS float*)lds;
        PG8_LAS float* S = (PG8_LAS float*)(lds + 4096);
#pragma unroll
        for (int ai = 0; ai < 2; ++ai)
#pragma unroll
            for (int m = 0; m < 4; ++m) {
                float s = 0.f;
#pragma unroll
                for (int bj = 0; bj < 2; ++bj)
#pragma unroll
                    for (int n = 0; n < 2; ++n) { const f32x4 x = v[ai][bj][m][n]; s += (x[0] * x[0] + x[1] * x[1]) + (x[2] * x[2] + x[3] * x[3]); }
                s += __shfl_xor(s, 16); s += __shfl_xor(s, 32);
                if (fq == 0) P[(ai * HALF + wr * 64 + m * 16 + fr) * 4 + wc] = s;
            }
        asm volatile("s_waitcnt lgkmcnt(0)" ::: "memory"); __builtin_amdgcn_s_barrier(); asm volatile("" ::: "memory");
        const int row = wid * 32 + (lane & 31);
        if (lane < 32) {
            const float t = (P[row * 4 + 0] + P[row * 4 + 1]) + (P[row * 4 + 2] + P[row * 4 + 3]);
            __hip_atomic_store(xbuf + ((size_t)(u.pm * BM + row) * 4 + u.pn), __builtin_bit_cast(unsigned, t), __ATOMIC_RELAXED, __HIP_MEMORY_SCOPE_AGENT);
        }
        asm volatile("s_waitcnt vmcnt(0)" ::: "memory");
        if (lane == 0) __hip_atomic_fetch_add(cnt + 64 * u.pm, 1u, __ATOMIC_RELAXED, __HIP_MEMORY_SCOPE_AGENT);
        if (wid == 0) {
            unsigned spins = 0;
            while ((unsigned)__builtin_amdgcn_readfirstlane(__hip_atomic_load(cnt + 64 * u.pm, __ATOMIC_RELAXED, __HIP_MEMORY_SCOPE_AGENT)) < 32u) { __builtin_amdgcn_s_sleep(2); if (++spins > (1u << 22)) break; }
            __builtin_amdgcn_fence(__ATOMIC_ACQUIRE, "agent");
        }
        asm volatile("s_waitcnt vmcnt(0) lgkmcnt(0)" ::: "memory"); __builtin_amdgcn_s_barrier(); asm volatile("" ::: "memory");
        if (lane < 32) {
            const unsigned* slot = xbuf + (size_t)(u.pm * BM + row) * 4; float t = 0.f;
#pragma unroll
            for (int q = 0; q < 4; ++q) t += __builtin_bit_cast(float, __hip_atomic_load(slot + q, __ATOMIC_RELAXED, __HIP_MEMORY_SCOPE_AGENT));
            S[row] = t;
        }
        asm volatile("s_waitcnt lgkmcnt(0)" ::: "memory"); __builtin_amdgcn_s_barrier(); asm volatile("" ::: "memory");
    }
};
struct EpiResNormMod {
    static constexpr bool PERM = false, AFTER_DRAIN = true;
    const float* base; float* out; bf16_t* H; const float* modb; const float* adab; const float* ng; int goff, shoff, scoff; RowSumSq st;
    __device__ __forceinline__ void fused(f32x4 (&acc)[2][2][4][2], const Unit& u, int wr, int wc, int fr, int fq, PG8_LAS unsigned char* lds, int wid, int lane) const {
        const int row0 = u.pm * BM + wr * 64 + fr, col0 = u.pn * BM + wc * 32 + 4 * fq; const int b = (u.pm * BM) >> 11;
        const float* mb = modb + (size_t)b * 6144;
#pragma unroll
        for (int bj = 0; bj < 2; ++bj)
#pragma unroll
            for (int n = 0; n < 2; ++n) { const int c = col0 + bj * HALF + n * 16; const f32x4 gv = *(const f32x4*)(mb + goff + c) + *(const f32x4*)(adab + goff + c);
#pragma unroll
                for (int ai = 0; ai < 2; ++ai)
#pragma unroll
                    for (int m = 0; m < 4; ++m) acc[ai][bj][m][n] *= gv; }
#pragma unroll
        for (int ai = 0; ai < 2; ++ai)
#pragma unroll
          for (int mp = 0; mp < 4; mp += 2) {
            f32x4 rv[2][2][2];
#pragma unroll
            for (int m = 0; m < 2; ++m)
#pragma unroll
                for (int bj = 0; bj < 2; ++bj)
#pragma unroll
                    for (int n = 0; n < 2; ++n) rv[m][bj][n] = *(const f32x4*)(base + (size_t)(row0 + ai * HALF + (mp + m) * 16) * 1024 + col0 + bj * HALF + n * 16);
#pragma unroll
            for (int m = 0; m < 2; ++m) { const size_t off = (size_t)(row0 + ai * HALF + (mp + m) * 16) * 1024 + col0;
#pragma unroll
                for (int bj = 0; bj < 2; ++bj)
#pragma unroll
                    for (int n = 0; n < 2; ++n) acc[ai][bj][mp + m][n] += rv[m][bj][n];
                {
                    char* xp = (char*)out + (off - col0) * 4 + (size_t)u.pn * 1024 + (wc * 4 + fq) * 32; const int mm = mp + m;
                    u32x4 w0, w1;
                    w0.x = cvt_pk_bf16(acc[ai][0][mm][0][0], acc[ai][0][mm][0][1]); w0.y = cvt_pk_bf16(acc[ai][0][mm][0][2], acc[ai][0][mm][0][3]); w0.z = cvt_pk_bf16(acc[ai][0][mm][1][0], acc[ai][0][mm][1][1]); w0.w = cvt_pk_bf16(acc[ai][0][mm][1][2], acc[ai][0][mm][1][3]);
                    w1.x = cvt_pk_bf16(acc[ai][1][mm][0][0], acc[ai][1][mm][0][1]); w1.y = cvt_pk_bf16(acc[ai][1][mm][0][2], acc[ai][1][mm][0][3]); w1.z = cvt_pk_bf16(acc[ai][1][mm][1][0], acc[ai][1][mm][1][1]); w1.w = cvt_pk_bf16(acc[ai][1][mm][1][2], acc[ai][1][mm][1][3]);
                    *(u32x4*)xp = w0; *(u32x4*)(xp + 16) = w1; }
                asm volatile("" : "+v"(acc[ai][0][mp + m][0]), "+v"(acc[ai][0][mp + m][1]), "+v"(acc[ai][1][mp + m][0]), "+v"(acc[ai][1][mp + m][1])); }
            asm volatile("" ::: "memory"); }
        st.run(acc, u, wr, wc, fr, fq, lds, wid, lane);
        const PG8_LAS float* S = (const PG8_LAS float*)(lds + 4096);
#pragma unroll
        for (int bj = 0; bj < 2; ++bj)
#pragma unroll
            for (int n = 0; n < 2; ++n) { const int c = col0 + bj * HALF + n * 16;
                const f32x4 g = *(const f32x4*)(ng + c), sc = *(const f32x4*)(mb + scoff + c) + *(const f32x4*)(adab + scoff + c) + 1.f, sh = *(const f32x4*)(mb + shoff + c) + *(const f32x4*)(adab + shoff + c);
                const f32x4 gs = g * sc;
#pragma unroll
                for (int ai = 0; ai < 2; ++ai)
#pragma unroll
                    for (int m = 0; m < 4; ++m) { const int r = ai * HALF + wr * 64 + m * 16 + fr; const float rstd = 1.f / sqrtf(S[r] * (1.f / 1024.f) + 1e-6f);
                        const f32x4 y = acc[ai][bj][m][n] * rstd * gs + sh;
                        unsigned w0 = cvt_pk_bf16(y[0], y[1]), w1 = cvt_pk_bf16(y[2], y[3]);
                        typedef unsigned u32x2 __attribute__((ext_vector_type(2)));
                        *(u32x2*)(H + (size_t)(u.pm * BM + r) * 1024 + c) = (u32x2){w0, w1}; } }
    }
};
struct EpiResNorm {
    static constexpr bool PERM = false, AFTER_DRAIN = true;
    const float* base; float* out; const float* modb; const float* adab; const float* fg; int goff; RowSumSq st;
    __device__ __forceinline__ void fused(f32x4 (&acc)[2][2][4][2], const Unit& u, int wr, int wc, int fr, int fq, PG8_LAS unsigned char* lds, int wid, int lane) const {
        const int row0 = u.pm * BM + wr * 64 + fr, col0 = u.pn * BM + wc * 32 + 4 * fq; const int b = (u.pm * BM) >> 11;
        const float* mb = modb + (size_t)b * 6144;
#pragma unroll
        for (int bj = 0; bj < 2; ++bj)
#pragma unroll
            for (int n = 0; n < 2; ++n) { const int c = col0 + bj * HALF + n * 16; const f32x4 gv = *(const f32x4*)(mb + goff + c) + *(const f32x4*)(adab + goff + c);
#pragma unroll
                for (int ai = 0; ai < 2; ++ai)
#pragma unroll
                    for (int m = 0; m < 4; ++m) acc[ai][bj][m][n] *= gv; }
#pragma unroll
        for (int ai = 0; ai < 2; ++ai)
#pragma unroll
          for (int mp = 0; mp < 4; mp += 2) {
            u32x4 rw[2][2];
#pragma unroll
            for (int m = 0; m < 2; ++m) { const char* xp = (const char*)base + (size_t)(row0 + ai * HALF + (mp + m) * 16) * 4096 + (size_t)u.pn * 1024 + (wc * 4 + fq) * 32;
                rw[m][0] = *(const u32x4*)xp; rw[m][1] = *(const u32x4*)(xp + 16); }
#pragma unroll
            for (int m = 0; m < 2; ++m) {
#pragma unroll
                for (int bj = 0; bj < 2; ++bj) { const u32x4 w = rw[m][bj];
                    acc[ai][bj][mp + m][0] += (f32x4){__builtin_bit_cast(float, w.x << 16), __builtin_bit_cast(float, w.x & 0xffff0000u), __builtin_bit_cast(float, w.y << 16), __builtin_bit_cast(float, w.y & 0xffff0000u)};
                    acc[ai][bj][mp + m][1] += (f32x4){__builtin_bit_cast(float, w.z << 16), __builtin_bit_cast(float, w.z & 0xffff0000u), __builtin_bit_cast(float, w.w << 16), __builtin_bit_cast(float, w.w & 0xffff0000u)}; }
                asm volatile("" : "+v"(acc[ai][0][mp + m][0]), "+v"(acc[ai][0][mp + m][1]), "+v"(acc[ai][1][mp + m][0]), "+v"(acc[ai][1][mp + m][1])); }
            asm volatile("" ::: "memory"); }
        st.run(acc, u, wr, wc, fr, fq, lds, wid, lane);
        const PG8_LAS float* S = (const PG8_LAS float*)(lds + 4096);
#pragma unroll
        for (int bj = 0; bj < 2; ++bj)
#pragma unroll
            for (int n = 0; n < 2; ++n) { const int c = col0 + bj * HALF + n * 16; const f32x4 g = *(const f32x4*)(fg + c);
#pragma unroll
                for (int ai = 0; ai < 2; ++ai)
#pragma unroll
                    for (int m = 0; m < 4; ++m) { const int r = ai * HALF + wr * 64 + m * 16 + fr; const float rstd = 1.f / sqrtf(S[r] * (1.f / 1024.f) + 1e-6f);
                        __builtin_nontemporal_store(acc[ai][bj][m][n] * rstd * g, (f32x4*)(out + (size_t)(u.pm * BM + r) * 1024 + c)); } }
    }
};

template <class Epi, class Sched, bool ALIGN_EPI = false, bool SP2 = false>
__device__ __forceinline__ void gemm_phase(PG8_LAS unsigned char* lds, const Gemm g, const Sched& S, const Epi& E) {
    int tid_o = threadIdx.x; asm volatile("" : "+v"(tid_o));
    const int tid = tid_o, wid = __builtin_amdgcn_readfirstlane(tid >> 6), lane = tid & 63, wr = wid >> 2, wc = wid & 3, fr = lane & 15, fq = lane >> 4;
    const int K = g.K, nt = K / BK;
    unsigned voffA[2], voffB[2];
#pragma unroll
    for (int i = 0; i < 2; ++i) { int R, C; stage_rc(tid * 16 + i * 8192, R, C); const int Rb = Epi::PERM ? ((R & ~31) + perm32(R & 31)) : R;
        voffA[i] = (unsigned)(R * g.lda + C) * 2u; voffB[i] = (unsigned)(Rb * g.ldb + C) * 2u; }
    const size_t kstep = (size_t)(BK * 2);
    const size_t hstepA = (size_t)HALF * g.lda * 2, hstepB = (size_t)HALF * g.ldb * 2;
    const unsigned ldsw = (unsigned)wid * 1024u;
    const int aoff = lds_byte(wr * 64 + fr, fq * 8), boff = lds_byte(wc * 32 + fr, fq * 8);
#define PG8_SA(b, h) (((b) * 2 + (h)) * HTB)
#define PG8_SB(b, h) ((4 + (b) * 2 + (h)) * HTB)
#define PG8_STAGE(bufoff, gbase, voff) do { _Pragma("unroll") for (int _i = 0; _i < 2; ++_i) \
        __builtin_amdgcn_global_load_lds((const unsigned*)((const char*)(gbase) + (voff)[_i]), (PG8_LAS unsigned*)(lds + (bufoff) + ldsw + _i * 8192), 16, 0, 0); } while (0)
#define PG8_LDA(dst, b, h) do { _Pragma("unroll") for (int m = 0; m < 4; ++m) _Pragma("unroll") for (int k = 0; k < 2; ++k) dst[m][k] = *(const PG8_LAS bf16x8*)(lds + PG8_SA(b, h) + aoff + m * 2048 + k * 1024); } while (0)
#define PG8_LDB(dst, b, h) do { _Pragma("unroll") for (int n = 0; n < 2; ++n) _Pragma("unroll") for (int k = 0; k < 2; ++k) dst[n][k] = *(const PG8_LAS bf16x8*)(lds + PG8_SB(b, h) + boff + n * 2048 + k * 1024); } while (0)
#define PG8_MMA(ai, bj, At, Bt) do { __builtin_amdgcn_s_setprio(1); _Pragma("unroll") for (int m = 0; m < 4; ++m) _Pragma("unroll") for (int n = 0; n < 2; ++n) _Pragma("unroll") for (int k = 0; k < 2; ++k) \
        acc[ai][bj][m][n] = __builtin_amdgcn_mfma_f32_16x16x32_bf16(Bt[n][k], At[m][k], acc[ai][bj][m][n], 0, 0, 0); __builtin_amdgcn_s_setprio(0); } while (0)
#define PG8_WAIT_V(n) asm volatile("s_waitcnt vmcnt(" #n ")" ::: "memory")
#define PG8_WAIT_L(n) asm volatile("s_waitcnt lgkmcnt(" #n ")" ::: "memory")
#define PG8_BAR __builtin_amdgcn_s_barrier()
#define PG8_SCHED __builtin_amdgcn_sched_barrier(0)
    Unit cur, nxt; int ui = 0;
    if (!S.next(0, cur)) return;
    f32x4 acc[2][2][4][2];
#pragma unroll
    for (int a = 0; a < 2; ++a)
#pragma unroll
        for (int b = 0; b < 2; ++b)
#pragma unroll
            for (int m = 0; m < 4; ++m)
#pragma unroll
                for (int n = 0; n < 2; ++n) acc[a][b][m][n] = (f32x4){0.f, 0.f, 0.f, 0.f};
    bf16x8 At[4][2], B0[2][2], B1[2][2];
    const char* cA = S.aptr(g, cur); const char* cB = S.bptr(g, cur);
    S.a_ready(cur);
    if constexpr (SP2) {
        PG8_STAGE(PG8_SB(0, 0), cB, voffB); PG8_STAGE(PG8_SB(0, 1), cB + hstepB, voffB); PG8_STAGE(PG8_SA(0, 0), cA, voffA); PG8_STAGE(PG8_SA(0, 1), cA + hstepA, voffA);
        if (wr == 1) PG8_BAR;
        PG8_WAIT_V(2); PG8_BAR;
        PG8_STAGE(PG8_SB(1, 0), cB + kstep, voffB); PG8_STAGE(PG8_SA(1, 0), cA + kstep, voffA); PG8_STAGE(PG8_SB(1, 1), cB + hstepB + kstep, voffB);
        PG8_WAIT_V(6); PG8_BAR;
    } else {
        PG8_STAGE(PG8_SB(0, 0), cB, voffB); PG8_STAGE(PG8_SA(0, 0), cA, voffA); PG8_STAGE(PG8_SB(0, 1), cB + hstepB, voffB); PG8_STAGE(PG8_SA(0, 1), cA + hstepA, voffA);
        if (wr == 1) PG8_BAR;
        PG8_WAIT_V(4); PG8_BAR;
        PG8_STAGE(PG8_SB(1, 0), cB + kstep, voffB); PG8_STAGE(PG8_SA(1, 0), cA + kstep, voffA); PG8_STAGE(PG8_SB(1, 1), cB + hstepB + kstep, voffB);
        PG8_WAIT_V(6); PG8_BAR;
    }
    for (;;) {
        const bool has_next = S.next(ui + 1, nxt);
        const char* nA = has_next ? S.aptr(g, nxt) : cA; const char* nB = has_next ? S.bptr(g, nxt) : cB;
        for (int t = 0; t < nt; t += 2) {
            const bool last = (t == nt - 2);
            const long d1 = (g.ksplit > 0 && t + 1 >= g.ksplit) ? g.adelta : 0, d2 = (g.ksplit > 0 && !last && t + 2 >= g.ksplit) ? g.adelta : 0, d3 = (g.ksplit > 0 && !last && t + 3 >= g.ksplit) ? g.adelta : 0;
            const char* a1 = cA + (size_t)(t + 1) * kstep + d1;
            const char* a2 = (last ? nA : cA + (size_t)(t + 2) * kstep) + d2; const char* b2 = last ? nB : cB + (size_t)(t + 2) * kstep;
            const char* a3 = (last ? nA : cA + (size_t)(t + 2) * kstep) + kstep + d3; const char* b3 = b2 + kstep;
            if (last && has_next) S.a_ready(nxt);
            if constexpr (SP2) {
            PG8_LDB(B0, 0, 0); PG8_LDB(B1, 0, 1); PG8_SCHED; PG8_LDA(At, 0, 0); PG8_STAGE(PG8_SA(1, 1), a1 + hstepA, voffA);
            PG8_WAIT_V(8); PG8_WAIT_L(0); PG8_BAR; PG8_MMA(0, 0, At, B0); PG8_MMA(0, 1, At, B1); PG8_BAR; PG8_SCHED;
            PG8_LDA(At, 0, 1); PG8_STAGE(PG8_SB(0, 0), b2, voffB); PG8_STAGE(PG8_SB(0, 1), b2 + hstepB, voffB); PG8_STAGE(PG8_SA(0, 0), a2, voffA);
            PG8_WAIT_V(8); PG8_WAIT_L(0); PG8_BAR; PG8_MMA(1, 0, At, B0); PG8_MMA(1, 1, At, B1); PG8_BAR; PG8_SCHED;
            PG8_LDB(B0, 1, 0); PG8_LDB(B1, 1, 1); PG8_SCHED; PG8_LDA(At, 1, 0); PG8_STAGE(PG8_SA(0, 1), a2 + hstepA, voffA);
            PG8_WAIT_V(8); PG8_WAIT_L(0); PG8_BAR; PG8_MMA(0, 0, At, B0); PG8_MMA(0, 1, At, B1); PG8_BAR; PG8_SCHED;
            PG8_LDA(At, 1, 1); PG8_STAGE(PG8_SB(1, 0), b3, voffB); PG8_STAGE(PG8_SB(1, 1), b3 + hstepB, voffB); PG8_STAGE(PG8_SA(1, 0), a3, voffA);
            PG8_WAIT_V(8); PG8_WAIT_L(0); PG8_BAR; PG8_MMA(1, 0, At, B0); PG8_MMA(1, 1, At, B1); PG8_BAR; PG8_SCHED;
            } else {
            PG8_LDB(B0, 0, 0); PG8_SCHED; PG8_LDA(At, 0, 0); PG8_STAGE(PG8_SA(1, 1), a1 + hstepA, voffA);
            PG8_WAIT_L(8); PG8_BAR; PG8_WAIT_L(0); PG8_MMA(0, 0, At, B0); PG8_BAR; PG8_SCHED;
            PG8_LDB(B1, 0, 1); PG8_STAGE(PG8_SB(0, 0), b2, voffB);
            PG8_BAR; PG8_WAIT_L(0); PG8_MMA(0, 1, At, B1); PG8_BAR;
            PG8_LDA(At, 0, 1); PG8_STAGE(PG8_SA(0, 0), a2, voffA);
            PG8_BAR; PG8_WAIT_L(0); PG8_MMA(1, 0, At, B0); PG8_BAR; PG8_SCHED;
            PG8_STAGE(PG8_SB(0, 1), b2 + hstepB, voffB);
            PG8_WAIT_V(6); PG8_BAR; PG8_MMA(1, 1, At, B1); PG8_BAR;
            PG8_LDB(B0, 1, 0); PG8_SCHED; PG8_LDA(At, 1, 0); PG8_STAGE(PG8_SA(0, 1), a2 + hstepA, voffA);
            PG8_WAIT_L(8); PG8_BAR; PG8_WAIT_L(0); PG8_MMA(0, 0, At, B0); PG8_BAR; PG8_SCHED;
            PG8_LDB(B1, 1, 1); PG8_STAGE(PG8_SB(1, 0), b3, voffB);
            PG8_BAR; PG8_WAIT_L(0); PG8_MMA(0, 1, At, B1); PG8_BAR;
            PG8_LDA(At, 1, 1); PG8_STAGE(PG8_SA(1, 0), a3, voffA);
            PG8_BAR; PG8_WAIT_L(0); PG8_MMA(1, 0, At, B0); PG8_BAR; PG8_SCHED;
            PG8_STAGE(PG8_SB(1, 1), b3 + hstepB, voffB);
            PG8_WAIT_V(6); PG8_BAR; PG8_MMA(1, 1, At, B1); PG8_BAR;
            }
        }
        if constexpr (ALIGN_EPI) { if (wr == 0) PG8_BAR; }
        if constexpr (!Epi::AFTER_DRAIN) { E(acc, cur, wr, wc, fr, fq); S.done(cur); }
        if (!has_next) break;
#pragma unroll
        for (int a = 0; a < 2; ++a)
#pragma unroll
            for (int b = 0; b < 2; ++b)
#pragma unroll
                for (int m = 0; m < 4; ++m)
#pragma unroll
                    for (int n = 0; n < 2; ++n) acc[a][b][m][n] = (f32x4){0.f, 0.f, 0.f, 0.f};
        cur = nxt; cA = nA; cB = nB; ++ui;
        if constexpr (ALIGN_EPI) { if (wr == 1) PG8_BAR; }
    }
    PG8_WAIT_V(0);
    if constexpr (!ALIGN_EPI) { if (wr == 0) PG8_BAR; }
    PG8_BAR;
    if constexpr (Epi::AFTER_DRAIN) { E.fused(acc, cur, wr, wc, fr, fq, lds, wid, lane); S.done(cur); }
#undef PG8_SA
#undef PG8_SB
#undef PG8_STAGE
#undef PG8_LDA
#undef PG8_LDB
#undef PG8_MMA
#undef PG8_WAIT_V
#undef PG8_WAIT_L
#undef PG8_BAR
#undef PG8_SCHED
}
}

constexpr int NWAVES = 8;
constexpr int D = 1024, BATCH = 8, SEQ = 2048, CTXL = 256;
constexpr int MLAT = BATCH * SEQ;
constexpr int MCTX = BATCH * CTXL;
constexpr int MTOT = MLAT + MCTX;
constexpr int FW = 512, CW = 512, NH = 8, HD = 64;
constexpr int PROJ = 2432, PROJP = 2560;
constexpr int DFF = 2816, F2 = 5632;
constexpr int MODW = 6 * D;

constexpr size_t MiB = 1u << 20;
constexpr size_t WS_CTL = 0, CTL_ZERO_BYTES = 1 * MiB;
constexpr size_t WS_PTRS = 128 * 1024;
constexpr size_t WS_ALT = 480 * 1024;
constexpr size_t WS_MOD = 256 * 1024;
constexpr size_t WS_WOUT = 1 * MiB;
constexpr size_t WS_UR = 3 * MiB;
constexpr size_t WS_H = 75 * MiB;
constexpr size_t WS_WIN = 111 * MiB;
constexpr size_t WS_ADFT = 116 * MiB;
constexpr size_t WS_UF = 124 * MiB;
constexpr size_t WS_PQT = 140 * MiB;
constexpr size_t OUT_YF = 0;
constexpr size_t REC_BYTES = 10496, REC_BATCH = (size_t)144 * 8 * 2 * REC_BYTES;
constexpr size_t WS_REC06 = 75 * MiB, OUT_REC7 = 32 * MiB;
constexpr size_t WS_VD = 237 * MiB;
constexpr size_t OUT_SGD = 56 * MiB, OUT_COEF = 60 * MiB;
static_assert(WS_REC06 + 7 * REC_BATCH <= WS_VD && OUT_REC7 + REC_BATCH <= OUT_SGD && WS_VD + 18 * MiB <= 256 * MiB, "record regions");
constexpr size_t WS_W2T = 512 * 1024, WS_A2T = WS_W2T + 131072, WS_G2T = WS_A2T + 131072;
constexpr size_t WS_Y0 = 3 * MiB, WS_Y1 = 19 * MiB;
constexpr size_t WS_FN = 52 * MiB;
constexpr size_t WS_AR = 75 * MiB;
constexpr size_t WS_WUP = 35 * MiB;
constexpr size_t WS_WDN = 46 * MiB;
constexpr size_t WS_H2 = 3 * MiB;
constexpr size_t WS_XBUF = 156 * MiB;
constexpr size_t WS_U2 = 160 * MiB;
constexpr size_t WS_ACT = 52 * MiB;
constexpr size_t WS_END = 256 * MiB;
constexpr int CW_BAR = 4096;
constexpr int CW_MODCNT = 3840;
constexpr int CW_SEAM = 16384, SEAM_BANK = 4096;

constexpr int RING_BYTES = 131072;
constexpr int LDSCTL_OFF = RING_BYTES, MISC_OFF = LDSCTL_OFF + 320;
constexpr int LDS_BYTES = 147456;

#define LAS __attribute__((address_space(3)))
typedef unsigned short bf16;
typedef unsigned v4u __attribute__((ext_vector_type(4)));
typedef unsigned v2u __attribute__((ext_vector_type(2)));
typedef float f32x4 __attribute__((ext_vector_type(4)));
#define LDS_WAIT() asm volatile("s_waitcnt lgkmcnt(0)" ::: "memory")
__device__ __forceinline__ unsigned f2bf(float f) { unsigned u = __builtin_bit_cast(unsigned, f); return (u + 0x7fffu + ((u >> 16) & 1u)) >> 16; }
__device__ __forceinline__ unsigned pk2(float lo, float hi) { return f2bf(lo) | (f2bf(hi) << 16); }
__device__ __forceinline__ float bf2f(unsigned short b) { return __builtin_bit_cast(float, ((unsigned)b) << 16); }
__device__ __forceinline__ float bflo(unsigned w) { return __builtin_bit_cast(float, w << 16); }
__device__ __forceinline__ float bfhi(unsigned w) { return __builtin_bit_cast(float, w & 0xffff0000u); }
__device__ __forceinline__ float sigmoidf_(float x) { return 1.f / (1.f + __expf(-x)); }
__device__ __forceinline__ float wave_sum(float v) {
#pragma unroll
    for (int o = 1; o < 64; o <<= 1) v += __shfl_xor(v, o);
    return v;
}

#define XB_TMO      128
#define XB_XCNT(j)  (256  + 64 * (j))
#define XB_XSUB(j)  (1280 + 64 * (j))
#define XB_XGEN(j)  (2304 + 64 * (j))
#define XB_TOP      3328
#define XB_TOPGEN   3392
#define XCD_BAR_WORDS 3456
#define XB_SPIN_CAP (1u << 20)
__device__ __forceinline__ unsigned xb_ld(unsigned* p)              { return __hip_atomic_load(p, __ATOMIC_RELAXED, __HIP_MEMORY_SCOPE_AGENT); }
__device__ __forceinline__ unsigned xb_add(unsigned* p, unsigned v) { return __hip_atomic_fetch_add(p, v, __ATOMIC_RELAXED, __HIP_MEMORY_SCOPE_AGENT); }
__device__ __forceinline__ unsigned xb_xcc_id() { return (unsigned)__builtin_amdgcn_s_getreg((3 << 11) | 20) & 0xFu; }
#define XB_SPIN(cond, bar) do { unsigned _sp = 0; while (cond) { __builtin_amdgcn_s_sleep(1); \
    if ((++_sp & 255u) == 0u) { if (xb_ld(&(bar)[XB_TMO])) break; if (_sp > XB_SPIN_CAP) { atomicAdd(&(bar)[XB_TMO], 1u); break; } } } } while (0)
struct XcdBarrier { unsigned* bar; unsigned x; volatile LAS unsigned* st; };
__device__ __forceinline__ XcdBarrier xcd_barrier_post(unsigned* bar, volatile LAS unsigned* st) {
    XcdBarrier b; b.bar = bar; b.x = xb_xcc_id(); b.st = st;
    if (threadIdx.x == 0) (void)xb_add(&bar[XB_XCNT(b.x)], 1u);
    return b;
}
__device__ __forceinline__ void xcd_barrier_complete(unsigned* bar, unsigned x, unsigned& nloc, unsigned& nx) {
    const unsigned G = gridDim.x * gridDim.y * gridDim.z;
    unsigned sum, cnt, mine, sp = 0u;
    for (;;) {
        sum = 0u; cnt = 0u; mine = 0u;
#pragma unroll
        for (unsigned j = 0; j < 16; ++j) { const unsigned c = xb_ld(&bar[XB_XCNT(j)]); sum += c; cnt += (c > 0u) ? 1u : 0u; mine = (j == x) ? c : mine; }
        if (sum == G) break;
        __builtin_amdgcn_s_sleep(1);
        if ((++sp & 255u) == 0u) { if (xb_ld(&bar[XB_TMO])) break; if (sp > XB_SPIN_CAP) { atomicAdd(&bar[XB_TMO], 1u); break; } }
    }
    nloc = mine > 0u ? mine : 1u; nx = cnt > 0u ? cnt : 1u;
}
__device__ __forceinline__ void xcd_barrier(const XcdBarrier& b) {
    asm volatile("s_waitcnt vmcnt(0)" ::: "memory");
    __syncthreads();
    if (threadIdx.x == 0) {
        unsigned* bar = b.bar;
        __builtin_amdgcn_s_waitcnt(0);
        unsigned nloc = b.st[0], nx = b.st[1];
        if (nloc == 0u) { xcd_barrier_complete(bar, b.x, nloc, nx); b.st[0] = nloc; b.st[1] = nx; }
        const unsigned old = xb_add(&bar[XB_XSUB(b.x)], 1u);
        const unsigned gen = old / nloc;
        if (old + 1u == (gen + 1u) * nloc) {
            __builtin_amdgcn_fence(__ATOMIC_RELEASE, "agent");
            asm volatile("s_waitcnt vmcnt(0)" ::: "memory");
            const unsigned og = xb_add(&bar[XB_TOP], 1u);
            const unsigned tg = og / nx;
            if (og + 1u == (tg + 1u) * nx) xb_add(&bar[XB_TOPGEN], 1u);
            else XB_SPIN(xb_ld(&bar[XB_TOPGEN]) == tg, bar);
            __builtin_amdgcn_fence(__ATOMIC_ACQUIRE, "agent");
            xb_add(&bar[XB_XGEN(b.x)], 1u);
            asm volatile("s_waitcnt vmcnt(0)" ::: "memory");
        } else {
            XB_SPIN(xb_ld(&bar[XB_XGEN(b.x)]) == gen, bar);
            __builtin_amdgcn_fence(__ATOMIC_ACQUIRE, "agent");
            asm volatile("s_waitcnt vmcnt(0)" ::: "memory");
        }
    }
    __syncthreads();
}

__device__ __forceinline__ void transpose_item(const float* W, int K, int N, bf16* WT, int row_off, LAS float* scr, int item, int lane) {
    const int nblk = N / 32, kb = item / nblk, nb = item % nblk, k0 = 64 * kb, n0 = 32 * nb;
    f32x4 v[8];
#pragma unroll
    for (int i = 0; i < 8; ++i) v[i] = *(const f32x4*)(W + (size_t)(k0 + (lane >> 3) + 8 * i) * N + n0 + 4 * (lane & 7));
#pragma unroll
    for (int i = 0; i < 8; ++i) { LAS float* d = scr + ((lane >> 3) + 8 * i) * 33 + 4 * (lane & 7); d[0] = v[i].x; d[1] = v[i].y; d[2] = v[i].z; d[3] = v[i].w; }
    LDS_WAIT(); asm volatile("" ::: "memory");
    const int c = lane & 7;
#pragma unroll
    for (int j = 0; j < 4; ++j) { const int n = (lane >> 3) + 8 * j; const LAS float* s = scr + (8 * c) * 33 + n;
        v4u o; o.x = pk2(s[0 * 33], s[1 * 33]); o.y = pk2(s[2 * 33], s[3 * 33]); o.z = pk2(s[4 * 33], s[5 * 33]); o.w = pk2(s[6 * 33], s[7 * 33]);
        *(v4u*)(WT + (size_t)(row_off + n0 + n) * K + k0 + 8 * c) = o; }
    LDS_WAIT(); asm volatile("" ::: "memory");
}

__device__ __forceinline__ void norm_mod_row(const float* xrow, const float* g, const float* modrow, const float* adab, int shoff, int scoff, bf16* orow, int lane) {
    f32x4 v[4]; float s = 0.f;
#pragma unroll
    for (int j = 0; j < 4; ++j) { v[j] = __builtin_nontemporal_load((const f32x4*)(xrow + 4 * lane + 256 * j)); s += (v[j].x * v[j].x + v[j].y * v[j].y) + (v[j].z * v[j].z + v[j].w * v[j].w); }
    const float rstd = 1.f / sqrtf(wave_sum(s) * (1.f / D) + 1e-6f);
#pragma unroll
    for (int j = 0; j < 4; ++j) { const int c = 4 * lane + 256 * j;
        const f32x4 gg = *(const f32x4*)(g + c);
        const f32x4 sc = *(const f32x4*)(modrow + scoff + c) + *(const f32x4*)(adab + scoff + c);
        const f32x4 sh = *(const f32x4*)(modrow + shoff + c) + *(const f32x4*)(adab + shoff + c);
        const f32x4 y = (v[j] * rstd * gg) * (sc + 1.f) + sh;
        v2u o; o.x = pk2(y.x, y.y); o.y = pk2(y.z, y.w);
        *(v2u*)(orow + c) = o; }
}


__device__ __forceinline__ float sigm_fast(float x) { return __builtin_amdgcn_rcpf(1.f + __builtin_amdgcn_exp2f(-1.442695041f * x)); }
__device__ __forceinline__ float tanh_fast(float x) { return 1.f - 2.f * __builtin_amdgcn_rcpf(1.f + __builtin_amdgcn_exp2f(2.885390082f * x)); }
template <int K> __device__ __forceinline__ float dpp_shr(float x) { return __builtin_bit_cast(float, __builtin_amdgcn_update_dpp(0, __builtin_bit_cast(int, x), 0x110 | K, 0xf, 0xf, true)); }
template <int C> __device__ __forceinline__ float dpp_ctl(float x) { return __builtin_bit_cast(float, __builtin_amdgcn_update_dpp(0, __builtin_bit_cast(int, x), C, 0xf, 0xf, true)); }
template <int K> __device__ __forceinline__ float dpp_shl(float x) { return __builtin_bit_cast(float, __builtin_amdgcn_update_dpp(0, __builtin_bit_cast(int, x), 0x100 | K, 0xf, 0xf, true)); }
__device__ __forceinline__ pg8::bf16x8 pack8(const float (&a)[4], const float (&b)[4]) {
    v4u w; w.x = pg8::cvt_pk_bf16(a[0], a[1]); w.y = pg8::cvt_pk_bf16(a[2], a[3]); w.z = pg8::cvt_pk_bf16(b[0], b[1]); w.w = pg8::cvt_pk_bf16(b[2], b[3]); return __builtin_bit_cast(pg8::bf16x8, w); }
__device__ __forceinline__ pg8::bf16x8 dop4(const f32x4 v) { v4u w; w.x = pg8::cvt_pk_bf16(v[0], v[1]); w.y = pg8::cvt_pk_bf16(v[2], v[3]); w.z = 0u; w.w = 0u; return __builtin_bit_cast(pg8::bf16x8, w); }
#define GRAM(Xf, Yf) __builtin_amdgcn_mfma_f32_16x16x32_bf16(Xf[1], Yf[1], __builtin_amdgcn_mfma_f32_16x16x32_bf16(Xf[0], Yf[0], z4, 0, 0, 0), 0, 0, 0)
__device__ __forceinline__ unsigned char* recbase(unsigned char* ws, unsigned char* outb, int b) {
    return b < 7 ? ws + WS_REC06 + (size_t)b * REC_BATCH : outb + OUT_REC7;
}

struct Args { const float* in[27]; float* out; unsigned char* ws; };

__global__ void __launch_bounds__(NWAVES * 64, 2) fwd_kernel(Args args) {
    extern __shared__ __attribute__((aligned(16))) unsigned char lds_raw[];
    LAS unsigned char* lds = (LAS unsigned char*)lds_raw;
    volatile LAS unsigned* MISC = (volatile LAS unsigned*)(lds + MISC_OFF);
    const int tid0 = threadIdx.x, wave = __builtin_amdgcn_readfirstlane(tid0 >> 6);
    const int G = gridDim.x, bx = blockIdx.x;
    const int gw = bx * NWAVES + wave, NGW = G * NWAVES;
    const int NGT = G * NWAVES * 64;
#define PHASE_VARS int tid = threadIdx.x; asm volatile("" : "+v"(tid)); const int lane = tid & 63; const int gt = bx * (NWAVES * 64) + tid; (void)lane; (void)gt;
    unsigned* ctl = (unsigned*)(args.ws + WS_CTL);
    unsigned char* const P_ws = args.ws; float* const P_outp = args.out;
#define P_outb ((unsigned char*)P_outp)
#define P_modb ((float*)(P_ws + WS_MOD))
#define TABP(k) ((const float*)(const __attribute__((address_space(1))) float*)(((const unsigned long long*)(P_ws + WS_PTRS))[k]))

    for (int u = tid0; u < (LDS_BYTES - LDSCTL_OFF) / 4; u += NWAVES * 64) ((LAS unsigned*)(lds + LDSCTL_OFF))[u] = 0u;
    __syncthreads();
    XcdBarrier bar = xcd_barrier_post(ctl + CW_BAR, MISC + 8);
#define GRID_BAR() xcd_barrier(bar)

#define MOD_GEMV(IT0, IT1) \
        for (int it = (IT0) + gw; it < (IT1); it += NGW) {     \
            const int cb = it >> 5, kc = it & 31, k0 = kc * 32, n0 = cb * 256 + lane * 4; \
            float sb[9]; \
            _Pragma("unroll") for (int b = 0; b < 9; ++b) { const float cv = (b < 8) ? args.in[1][b * D + k0 + (lane & 31)] : args.in[3][k0 + (lane & 31)]; sb[b] = cv / (1.f + __expf(-cv)); } \
            f32x4 acc[9]; \
            _Pragma("unroll") for (int b = 0; b < 9; ++b) acc[b] = (f32x4){0.f, 0.f, 0.f, 0.f}; \
            _Pragma("unroll") for (int kk = 0; kk < 32; ++kk) { \
                const f32x4 wv = *(const f32x4*)(args.in[4] + (size_t)(k0 + kk) * MODW + n0); \
                _Pragma("unroll") for (int b = 0; b < 9; ++b) { const float s = __builtin_bit_cast(float, __builtin_amdgcn_readlane(__builtin_bit_cast(int, sb[b]), kk)); acc[b] += wv * s; } \
            } \
            _Pragma("unroll") for (int b = 0; b < 9; ++b) { float* p = P_modb + b * MODW + n0; atomicAdd(p, acc[b].x); atomicAdd(p + 1, acc[b].y); atomicAdd(p + 2, acc[b].z); atomicAdd(p + 3, acc[b].w); } \
        }
    {
        PHASE_VARS
        unsigned* modcnt = ctl + CW_MODCNT;
        MOD_GEMV(0, 8 * 32)
        asm volatile("s_waitcnt vmcnt(0)" ::: "memory");
        __syncthreads();
        if (tid == 0 && bx * NWAVES < 256) { __builtin_amdgcn_fence(__ATOMIC_RELEASE, "agent"); asm volatile("s_waitcnt vmcnt(0)" ::: "memory"); const int mine = (bx * NWAVES < 256) ? ((256 - bx * NWAVES) < NWAVES ? (256 - bx * NWAVES) : NWAVES) : 0;
            __hip_atomic_fetch_add(modcnt, (unsigned)mine, __ATOMIC_RELAXED, __HIP_MEMORY_SCOPE_AGENT); }
        LAS float* scr = (LAS float*)(lds + wave * 16384);
        bf16* WinT = (bf16*)(P_ws + WS_WIN);
        constexpr int I_IN = (D / 64) * (PROJ / 32);
        for (int it = gw; it < I_IN; it += NGW) transpose_item(args.in[8], D, PROJ, WinT, 0, scr, it, lane);
        for (int i = gt; i < (PROJP - PROJ) * D / 8; i += NGT) *(v4u*)(WinT + (size_t)PROJ * D + (size_t)i * 8) = (v4u){0u, 0u, 0u, 0u};
        {
            bf16* W2T = (bf16*)(P_ws + WS_W2T); bf16* A2T = (bf16*)(P_ws + WS_A2T); bf16* G2T = (bf16*)(P_ws + WS_G2T);
            for (int i = gt; i < 2 * CW * 64; i += NGT) { const int d = i >> 15, c = (i >> 6) & 511, rr = i & 63;
                W2T[i] = (bf16)f2bf(args.in[11][(size_t)(d * 64 + rr) * CW + c]); A2T[i] = (bf16)f2bf(args.in[13][(size_t)(d * 64 + rr) * CW + c]); }
            for (int i = gt; i < CW * 128; i += NGT) { const int c = i >> 7, q = i & 127; G2T[i] = (bf16)f2bf(args.in[14][(size_t)q * CW + c]); }
        }
        if (bx == 0 && tid < 27) ((const float**)(P_ws + WS_PTRS))[tid] = args.in[tid];
        __syncthreads();
        LAS float* tab = (LAS float*)lds;
        for (int m = tid; m < 2048; m += NWAVES * 64) { float sn, cs; sincospif((float)m * (1.f / 1024.f), &sn, &cs); tab[2 * m] = cs; tab[2 * m + 1] = sn; }
        __syncthreads();
        bf16* Adft = (bf16*)(P_ws + WS_ADFT);
        const float sc = 0.00276213586400995f;
        for (int i = gt; i < 2048 * 256; i += NGT) {
            const int r = i >> 8, ch = i & 255, t0 = ch * 8, k = r & 1023; const bool isS = r >= 1024;
            float v[8];
#pragma unroll
            for (int j = 0; j < 8; ++j) { const int m = (k * (t0 + j)) & 2047; v[j] = (isS ? tab[2 * m + 1] : tab[2 * m]) * sc; }
            v4u o; o.x = pk2(v[0], v[1]); o.y = pk2(v[2], v[3]); o.z = pk2(v[4], v[5]); o.w = pk2(v[6], v[7]);
            *(v4u*)(Adft + (size_t)r * 2048 + (size_t)ch * 8) = o;
        }
        if (tid == 0) { unsigned spins = 0;
            while (__hip_atomic_load(modcnt, __ATOMIC_RELAXED, __HIP_MEMORY_SCOPE_AGENT) < 256u) { __builtin_amdgcn_s_sleep(2); if (++spins > (1u << 22)) break; }
            __builtin_amdgcn_fence(__ATOMIC_ACQUIRE, "agent");
            asm volatile("s_waitcnt vmcnt(0)" ::: "memory"); }
        __syncthreads();
        {
            const float* const P_x = args.in[0];
            const float* const P_ctx = args.in[2];
            const float* const P_ada_b = args.in[5];
            const float* const P_norm1_g = args.in[6];
            bf16* Hb = (bf16*)(P_ws + WS_H);
            for (int row = gw; row < MTOT; row += NGW) {
                const float* xr = row < MLAT ? P_x + (size_t)row * D : P_ctx + (size_t)(row - MLAT) * D;
                const int mb = row < MLAT ? (row >> 11) : 8;
                norm_mod_row(xr, P_norm1_g, P_modb + (size_t)mb * MODW, P_ada_b, 0, D, Hb + (size_t)row * D, lane);
            }
        }
    }
    GRID_BAR();

    REPS(10)
    {
        PHASE_VARS
        const float* const P_w_in = TABP(8);
        pg8::Gemm g{(const bf16*)(P_ws + WS_H), (const bf16*)(P_ws + WS_WIN), MTOT, PROJP, D, D, D, 0, 0}; pg8::StaticOrder S; S.init(MTOT, PROJP, G, bx);
        pg8::EpiU E{(bf16*)(P_ws + WS_UF), (bf16*)(P_ws + WS_UR)};
        pg8::gemm_phase<pg8::EpiU, pg8::StaticOrder, true, true>(lds, g, S, E);
    }
    GRID_BAR();

    REPS(1)
    {
        PHASE_VARS
        const int g = lane >> 4, n = lane & 15;
        const bf16* U = (const bf16*)(P_ws + WS_UF); bf16* PQt = (bf16*)(P_ws + WS_PQT);
        LAS float* twt = (LAS float*)(lds + 132096);
        if (tid < 64) { float sn, cs; sincospif((float)tid * (1.f / 32.f), &sn, &cs); twt[2 * tid] = cs; twt[2 * tid + 1] = sn; }
        __syncthreads();
        pg8::bf16x8 tw[8][2];
#pragma unroll
        for (int lt = 0; lt < 8; ++lt)
#pragma unroll
            for (int ks = 0; ks < 2; ++ks) { float v[8];
#pragma unroll
                for (int i = 0; i < 8; ++i) { const int l = 16 * (lt & 3) + n, c = 32 * ks + 8 * g + i; v[i] = twt[2 * ((l * c) & 63) + (lt >> 2)]; }
                v4u w; w.x = pg8::cvt_pk_bf16(v[0], v[1]); w.y = pg8::cvt_pk_bf16(v[2], v[3]); w.z = pg8::cvt_pk_bf16(v[4], v[5]); w.w = pg8::cvt_pk_bf16(v[6], v[7]); tw[lt][ks] = __builtin_bit_cast(pg8::bf16x8, w); }
        LAS unsigned short* stg = (LAS unsigned short*)(lds + wave * 16384);
        for (int it = gw; it < BATCH * 8 * 32; it += NGW) {
            const int tb = it & 31, gq = (it >> 5) & 7, b = it >> 8;
#pragma unroll
            for (int tt = 0; tt < 4; ++tt) {
                const bf16* ur = U + (size_t)(b * SEQ + tb * 64 + tt * 16 + n) * FW + gq * 64 + 8 * g;
                const pg8::bf16x8 b0 = *(const pg8::bf16x8*)ur, b1 = *(const pg8::bf16x8*)(ur + 32);
#pragma unroll
                for (int lt = 0; lt < 8; ++lt) {
                    f32x4 acc = __builtin_amdgcn_mfma_f32_16x16x32_bf16(tw[lt][0], b0, (f32x4){0.f, 0.f, 0.f, 0.f}, 0, 0, 0);
                    acc = __builtin_amdgcn_mfma_f32_16x16x32_bf16(tw[lt][1], b1, acc, 0, 0, 0);
#pragma unroll
                    for (int e = 0; e < 4; ++e) stg[(16 * lt + 4 * g + e) * 64 + tt * 16 + n] = (unsigned short)f2bf(acc[e]);
                }
                asm volatile("" ::: "memory");
            }
            LDS_WAIT(); asm volatile("" ::: "memory");
            {
                float alt = 0.f;
#pragma unroll
                for (int q = 0; q < 8; ++q) { const v4u w = *(const LAS v4u*)(stg + lane * 64 + q * 8);
                    alt += (bflo(w.x) - bfhi(w.x)) + (bflo(w.y) - bfhi(w.y)) + (bflo(w.z) - bfhi(w.z)) + (bflo(w.w) - bfhi(w.w)); }
                atomicAdd((float*)(P_ws + WS_ALT) + b * 512 + gq * 64 + lane, alt);
            }
            bf16* pbase = PQt + (size_t)(b * 512 + gq * 64) * 4096 + tb * 64;
#pragma unroll
            for (int q = 0; q < 16; ++q) { const int ch = q * 64 + lane, rw = ch >> 3, cc = ch & 7;
                const v4u w = *(const LAS v4u*)(stg + rw * 64 + cc * 8);
                *(v4u*)(pbase + (size_t)(rw & 63) * 4096 + (rw >> 6) * 2048 + cc * 8) = w; }
            LDS_WAIT(); asm volatile("" ::: "memory");
        }
    }
    GRID_BAR();

    REPS(11)
    {
        PHASE_VARS
        pg8::Gemm g{(const bf16*)(P_ws + WS_ADFT), (const bf16*)(P_ws + WS_PQT), 2048, 4096, 1024, 2048, 4096, 0, 0}; pg8::DftOrder S{G, bx};
        pg8::EpiYpart E{(bf16*)(P_outb + OUT_YF)};
        pg8::gemm_phase<pg8::EpiYpart, pg8::DftOrder, true, true>(lds, g, S, E);
    }
    GRID_BAR();

    REPS(2)
    {
        PHASE_VARS
        const bool nost = (PROBE_DUP == 2 && (PROBE_VAR == 1 || PROBE_VAR == 5) && rep_ == 1), nold = (PROBE_DUP == 2 && PROBE_VAR == 5 && rep_ == 1);
        const int h = bx & 7, nhb = G >> 3, hb = bx >> 3;
        const bf16* Ur = (const bf16*)(P_ws + WS_UR);
        constexpr int WROW = 144;
        LAS unsigned char* WL = lds;
        LAS float* CWL = (LAS float*)(lds + 36864);
        LAS float* PRL = (LAS float*)(lds + 36864 + 2304);
        constexpr int TS = 20, TT = 64 * TS;
        LAS unsigned short* tl = (LAS unsigned short*)(lds + 40960 + wave * 8192);
        {
            const float* const P_rconv_w = TABP(9);
            const float* const P_decay_w0 = TABP(10);
            const float* const P_iclr_a0 = TABP(12);
            const float* const P_k_k = TABP(15);
            const float* const P_k_a = TABP(16);
            const float* const P_r_k = TABP(17);
            const bf16* W2T = (const bf16*)(P_ws + WS_W2T); const bf16* A2T = (const bf16*)(P_ws + WS_A2T);
            for (int i = tid; i < 4 * 64 * 8; i += NWAVES * 64) {
                const int pc = i & 7, ch = (i >> 3) & 63, td = i >> 9, typ = td >> 1, d = td & 1;
                const bf16* srcp = (typ ? A2T : W2T) + ((size_t)(d * CW + h * 64 + ch)) * 64 + pc * 8;
                *(LAS v4u*)(WL + (td * 64 + ch) * WROW + pc * 16) = *(const v4u*)srcp;
            }
            for (int i = tid; i < 9 * 64; i += NWAVES * 64) { const int ch = i & 63, ta = i >> 6, tap = ta / 3, a = ta - tap * 3; CWL[i] = P_rconv_w[tap * 1536 + a * CW + h * 64 + ch]; }
            for (int i = tid; i < 7 * 64; i += NWAVES * 64) { const int ch = i & 63, p = i >> 6;
                const float v = p == 0 ? P_decay_w0[h * 64 + ch] : p == 1 ? P_decay_w0[CW + h * 64 + ch] : p == 2 ? P_iclr_a0[h * 64 + ch] : p == 3 ? P_iclr_a0[CW + h * 64 + ch]
                              : p == 4 ? P_k_k[h * 64 + ch] : p == 5 ? P_k_a[h * 64 + ch] : P_r_k[h * 64 + ch];
                PRL[i] = v; }
        }
        __syncthreads();
        for (int bi = hb * NWAVES + wave; bi < BATCH * 144; bi += nhb * NWAVES) {
            int ln = lane; asm volatile("" : "+v"(ln)); ln &= 63;
            const int g = ln >> 4, n = ln & 15, rowD0 = 4 * g;
            const int b = bi / 144, sc = bi - b * 144;
            const bool lat = sc >= 16;
            const int t0 = lat ? (sc - 16) * 16 : sc * 16, T = lat ? SEQ : CTXL, rowbase = lat ? b * SEQ : MLAT + b * CTXL;
            const int t = t0 + n, row = rowbase + t;
            const bf16* ur = nold ? Ur + (size_t)(ln & 15) * 2048 + 4096 : Ur + (size_t)row * 2048;
            const int om = (t > 0) ? -2048 : 0, op = (t < T - 1) ? 2048 : 0; const float m0 = (t > 0) ? 1.f : 0.f, m2 = (t < T - 1) ? 1.f : 0.f;
            v2u cu[3][4][3];
#pragma unroll
            for (int a = 0; a < 3; ++a)
#pragma unroll
                for (int ct = 0; ct < 4; ++ct) { const int col = a * CW + h * 64 + 16 * ct + 4 * g;
                    cu[a][ct][0] = *(const v2u*)(ur + om + col); cu[a][ct][1] = *(const v2u*)(ur + col); cu[a][ct][2] = *(const v2u*)(ur + op + col); }
            v4u wraw[2][2]; pg8::bf16x8 bad[2][2];
#pragma unroll
            for (int d = 0; d < 2; ++d)
#pragma unroll
                for (int ks = 0; ks < 2; ++ks) { wraw[d][ks] = *(const v4u*)(ur + 1536 + d * 64 + 32 * ks + 8 * g); bad[d][ks] = *(const pg8::bf16x8*)(ur + 1664 + d * 64 + 32 * ks + 8 * g); }
            f32x4 accw[2][4], acca[2][4];
#pragma unroll
            for (int d = 0; d < 2; ++d) {
#pragma unroll
                for (int ct = 0; ct < 4; ++ct) { accw[d][ct] = (f32x4){0.f, 0.f, 0.f, 0.f}; acca[d][ct] = (f32x4){0.f, 0.f, 0.f, 0.f}; }
#pragma unroll
                for (int ks = 0; ks < 2; ++ks) {
                    const v4u wr_ = wraw[d][ks]; v4u wt;
                    wt.x = pg8::cvt_pk_bf16(tanh_fast(bflo(wr_.x)), tanh_fast(bfhi(wr_.x))); wt.y = pg8::cvt_pk_bf16(tanh_fast(bflo(wr_.y)), tanh_fast(bfhi(wr_.y)));
                    wt.z = pg8::cvt_pk_bf16(tanh_fast(bflo(wr_.z)), tanh_fast(bfhi(wr_.z))); wt.w = pg8::cvt_pk_bf16(tanh_fast(bflo(wr_.w)), tanh_fast(bfhi(wr_.w)));
                    const pg8::bf16x8 bwd = __builtin_bit_cast(pg8::bf16x8, wt);
#pragma unroll
                    for (int ct = 0; ct < 4; ++ct) {
                        const LAS unsigned char* wp = WL + (d * 64 + 16 * ct + n) * WROW + (32 * ks + 8 * g) * 2;
                        accw[d][ct] = __builtin_amdgcn_mfma_f32_16x16x32_bf16(*(const LAS pg8::bf16x8*)wp, bwd, accw[d][ct], 0, 0, 0);
                        acca[d][ct] = __builtin_amdgcn_mfma_f32_16x16x32_bf16(*(const LAS pg8::bf16x8*)(wp + 128 * WROW), bad[d][ks], acca[d][ct], 0, 0, 0);
                    }
                }
            }
            float Rv[4][4], Kv[4][4], Vv[4][4];
#pragma unroll
            for (int a = 0; a < 3; ++a)
#pragma unroll
                for (int ct = 0; ct < 4; ++ct) {
                    const int cb = a * 64 + 16 * ct + 4 * g;
                    const v2u u0 = cu[a][ct][0], u1 = cu[a][ct][1], u2 = cu[a][ct][2];
                    const f32x4 c0 = *(const LAS f32x4*)(CWL + cb) * m0, c1 = *(const LAS f32x4*)(CWL + 192 + cb), c2 = *(const LAS f32x4*)(CWL + 384 + cb) * m2;
                    const float x0 = c0.x * bflo(u0.x) + c1.x * bflo(u1.x) + c2.x * bflo(u2.x);
                    const float x1 = c0.y * bfhi(u0.x) + c1.y * bfhi(u1.x) + c2.y * bfhi(u2.x);
                    const float x2 = c0.z * bflo(u0.y) + c1.z * bflo(u1.y) + c2.z * bflo(u2.y);
                    const float x3 = c0.w * bfhi(u0.y) + c1.w * bfhi(u1.y) + c2.w * bfhi(u2.y);
                    if (a == 0) { Rv[ct][0] = x0; Rv[ct][1] = x1; Rv[ct][2] = x2; Rv[ct][3] = x3; }
                    else if (a == 1) { Kv[ct][0] = x0; Kv[ct][1] = x1; Kv[ct][2] = x2; Kv[ct][3] = x3; }
                    else { Vv[ct][0] = x0; Vv[ct][1] = x1; Vv[ct][2] = x2; Vv[ct][3] = x3; }
                }
            float KKv[4][4]; float ss = 0.f;
#pragma unroll
            for (int ct = 0; ct < 4; ++ct) { const f32x4 kkp = *(const LAS f32x4*)(PRL + 4 * 64 + 16 * ct + 4 * g);
                KKv[ct][0] = Kv[ct][0] * kkp.x; KKv[ct][1] = Kv[ct][1] * kkp.y; KKv[ct][2] = Kv[ct][2] * kkp.z; KKv[ct][3] = Kv[ct][3] * kkp.w;
#pragma unroll
                for (int e = 0; e < 4; ++e) ss += KKv[ct][e] * KKv[ct][e]; }
            ss += __shfl_xor(ss, 16); ss += __shfl_xor(ss, 32);
            { const float rs = 1.f / sqrtf(ss + 1e-12f);
#pragma unroll
              for (int ct = 0; ct < 4; ++ct)
#pragma unroll
                  for (int e = 0; e < 4; ++e) KKv[ct][e] *= rs; }
#pragma unroll
            for (int ct = 0; ct < 4; ++ct)
#pragma unroll
                for (int e = 0; e < 4; e += 2) { const unsigned vp_ = pg8::cvt_pk_bf16(Vv[ct][e], Vv[ct][e + 1]); tl[2 * TT + (16 * ct + 4 * g + e) * TS + n] = (unsigned short)vp_; tl[2 * TT + (16 * ct + 4 * g + e + 1) * TS + n] = (unsigned short)(vp_ >> 16); }
            LDS_WAIT(); asm volatile("" ::: "memory");
            {
                unsigned char* vd = P_ws + WS_VD + ((size_t)bi * 8 + h) * 2048;
#pragma unroll
                for (int it = 0; it < 4; ++it) { const v2u w = *(const LAS v2u*)(tl + 2 * TT + (16 * it + n) * TS + 4 * g); if (!nost) __builtin_nontemporal_store(w, (v2u*)(vd + it * 512 + ln * 8)); }
            }
            float cpart = 0.f;
#pragma unroll 1
            for (int d = 0; d < 2; ++d) {
                unsigned char* rec = recbase(P_ws, P_outb, b) + ((size_t)(sc * 8 + h) * 2 + d) * REC_BYTES;
                f32x4 aw[4], aa[4];
#pragma unroll
                for (int ct = 0; ct < 4; ++ct) {
#pragma unroll
                    for (int e = 0; e < 4; ++e) { aw[ct][e] = d ? accw[1][ct][e] : accw[0][ct][e]; aa[ct][e] = d ? acca[1][ct][e] : acca[0][ct][e]; } }
                pg8::bf16x8 Qf[2], Pf[2], Ktf[2], Btf[2];
#pragma unroll
                for (int m = 0; m < 2; ++m) {
                    float Qv[2][4], Pv[2][4], Ktv[2][4], Btv[2][4];
#pragma unroll
                    for (int cc = 0; cc < 2; ++cc) {
                        const int ct = 2 * m + cc, cb = 16 * ct + 4 * g;
                        const f32x4 w0p = *(const LAS f32x4*)(PRL + d * 64 + cb), a0p = *(const LAS f32x4*)(PRL + (2 + d) * 64 + cb), kap = *(const LAS f32x4*)(PRL + 5 * 64 + cb), rkp = *(const LAS f32x4*)(PRL + 6 * 64 + cb);
                        float GGv[4];
#pragma unroll
                        for (int e = 0; e < 4; ++e) {
                            const float av = sigm_fast(a0p[e] + aa[ct][e]);
                            const float kd = Kv[ct][e] * (1.f + (av - 1.f) * kap[e]), bd = KKv[ct][e] * av;
                            const float lw = -0.875038532f * sigm_fast(w0p[e] + aw[ct][e]);
                            cpart += Rv[ct][e] * kd * rkp[e];
                            float pre = lw; pre += dpp_shr<1>(pre); pre += dpp_shr<2>(pre); pre += dpp_shr<4>(pre); pre += dpp_shr<8>(pre);
                            float tot = lw; tot += dpp_ctl<0xB1>(tot); tot += dpp_ctl<0x4E>(tot); tot += dpp_ctl<0x141>(tot); tot += dpp_ctl<0x140>(tot);
                            const float cs = d ? (tot - pre + lw) : pre;
                            const float E = __builtin_amdgcn_exp2f(cs), Ei = __builtin_amdgcn_exp2f(-cs), Ex = __builtin_amdgcn_exp2f(cs - lw), gg = __builtin_amdgcn_exp2f(tot);
                            Qv[cc][e] = KKv[ct][e] * Ex; Pv[cc][e] = Rv[ct][e] * E; Ktv[cc][e] = kd * Ei; Btv[cc][e] = bd * Ei; GGv[e] = gg;
                            const int ch = 16 * ct + 4 * g + e;
                            { const unsigned kb_ = pg8::cvt_pk_bf16(Ktv[cc][e] * gg, -Btv[cc][e] * gg); tl[ch * TS + n] = (unsigned short)kb_; tl[TT + ch * TS + n] = (unsigned short)(kb_ >> 16); }
                        }
                        if (n == 0) *(LAS f32x4*)((LAS unsigned char*)tl + 7680 + 64 * ct + ln) = (f32x4){GGv[0], GGv[1], GGv[2], GGv[3]};
                        asm volatile("" ::: "memory");
                    }
                    Qf[m] = pack8(Qv[0], Qv[1]); Pf[m] = pack8(Pv[0], Pv[1]); Ktf[m] = pack8(Ktv[0], Ktv[1]); Btf[m] = pack8(Btv[0], Btv[1]);
                }
                if (!nost) { __builtin_nontemporal_store(Qf[0], (pg8::bf16x8*)(rec + ln * 16)); __builtin_nontemporal_store(Qf[1], (pg8::bf16x8*)(rec + 1024 + ln * 16));
                __builtin_nontemporal_store(Pf[0], (pg8::bf16x8*)(rec + 2048 + ln * 16)); __builtin_nontemporal_store(Pf[1], (pg8::bf16x8*)(rec + 3072 + ln * 16)); }
                const f32x4 z4 = (f32x4){0.f, 0.f, 0.f, 0.f};
                f32x4 AkT = GRAM(Ktf, Qf), Mm = GRAM(Qf, Btf), Mt = GRAM(Btf, Qf), BkT = GRAM(Ktf, Pf), BbT = GRAM(Btf, Pf);
                f32x4 R1;
#pragma unroll
                for (int e = 0; e < 4; ++e) {
                    const int rw = rowD0 + e;
                    const bool rb4c = d ? (rw > n) : (rw < n), cb4r = d ? (n > rw) : (n < rw), eq = (rw == n);
                    AkT[e] = rb4c ? AkT[e] : 0.f; Mm[e] = cb4r ? Mm[e] : 0.f; Mt[e] = rb4c ? Mt[e] : 0.f;
                    BkT[e] = (rb4c || eq) ? BkT[e] : 0.f; BbT[e] = (rb4c || eq) ? BbT[e] : 0.f;
                    R1[e] = (eq ? 1.f : 0.f) - Mt[e];
                }
                const pg8::bf16x8 oM = dop4(Mm), oMt = dop4(Mt);
                const f32x4 M2 = __builtin_amdgcn_mfma_f32_16x16x32_bf16(oMt, oM, z4, 0, 0, 0), Mt2 = __builtin_amdgcn_mfma_f32_16x16x32_bf16(oM, oMt, z4, 0, 0, 0);
                const pg8::bf16x8 oM2 = dop4(M2), oMt2 = dop4(Mt2);
                const f32x4 M4 = __builtin_amdgcn_mfma_f32_16x16x32_bf16(oMt2, oM2, z4, 0, 0, 0), Mt4 = __builtin_amdgcn_mfma_f32_16x16x32_bf16(oM2, oMt2, z4, 0, 0, 0);
                const pg8::bf16x8 oM4 = dop4(M4), oMt4 = dop4(Mt4);
                const f32x4 M8 = __builtin_amdgcn_mfma_f32_16x16x32_bf16(oMt4, oM4, z4, 0, 0, 0);
                const f32x4 R2 = __builtin_amdgcn_mfma_f32_16x16x32_bf16(oM2, dop4(R1), R1, 0, 0, 0);
                const f32x4 R3 = __builtin_amdgcn_mfma_f32_16x16x32_bf16(oM4, dop4(R2), R2, 0, 0, 0);
                const f32x4 Tt = __builtin_amdgcn_mfma_f32_16x16x32_bf16(dop4(M8), dop4(R3), R3, 0, 0, 0);
                { v4u ma; ma.x = pg8::cvt_pk_bf16(AkT[0], AkT[1]); ma.y = pg8::cvt_pk_bf16(AkT[2], AkT[3]); ma.z = pg8::cvt_pk_bf16(Tt[0], Tt[1]); ma.w = pg8::cvt_pk_bf16(Tt[2], Tt[3]);
                  if (!nost) __builtin_nontemporal_store(ma, (v4u*)(rec + 8192 + ln * 16));
                  v4u mb; mb.x = pg8::cvt_pk_bf16(BkT[0], BkT[1]); mb.y = pg8::cvt_pk_bf16(BkT[2], BkT[3]); mb.z = pg8::cvt_pk_bf16(-BbT[0], -BbT[1]); mb.w = pg8::cvt_pk_bf16(-BbT[2], -BbT[3]);
                  if (!nost) __builtin_nontemporal_store(mb, (v4u*)(rec + 9216 + ln * 16)); }
                LDS_WAIT(); asm volatile("" ::: "memory");
#pragma unroll
                for (int jt = 0; jt < 4; ++jt) { const v2u k2 = *(const LAS v2u*)(tl + (16 * jt + n) * TS + 4 * g), b2 = *(const LAS v2u*)(tl + TT + (16 * jt + n) * TS + 4 * g);
                    if (!nost) __builtin_nontemporal_store((v4u){k2.x, k2.y, b2.x, b2.y}, (v4u*)(rec + 4096 + jt * 1024 + ln * 16)); }
                if (ln < 16 && !nost) *(f32x4*)(rec + 10240 + ln * 16) = *(const LAS f32x4*)((const LAS unsigned char*)tl + 7680 + ln * 16);
                LDS_WAIT(); asm volatile("" ::: "memory");
            }
            if (lat) {
                int ln2 = lane; asm volatile("" : "+v"(ln2)); ln2 &= 63;
                const int g2_ = ln2 >> 4, row2 = rowbase + t0 + (ln2 & 15);
                const bf16* ur2 = Ur + (size_t)row2 * 2048;
                cpart += __shfl_xor(cpart, 16); cpart += __shfl_xor(cpart, 32);
                if (g2_ == 0 && !nost) ((float*)(P_outb + OUT_COEF))[(size_t)row2 * 8 + h] = cpart;
                if (!nost) {
                    const v2u sgw = *(const v2u*)(ur2 + 1792 + 16 * h + 4 * g2_);
                    bf16* sg = (bf16*)(P_outb + OUT_SGD) + (size_t)row2 * 128 + 16 * h + 4 * g2_;
                    *(v2u*)sg = (v2u){pg8::cvt_pk_bf16(sigm_fast(bflo(sgw.x)), sigm_fast(bfhi(sgw.x))), pg8::cvt_pk_bf16(sigm_fast(bflo(sgw.y)), sigm_fast(bfhi(sgw.y)))};
                }
            }
        }
    }
    GRID_BAR();

    REPS(3)
    {
        PHASE_VARS
        const bool pvA = (PROBE_DUP == 3 && PROBE_VAR == 2 && rep_ == 1), pvB = (PROBE_DUP == 3 && (PROBE_VAR == 3 || PROBE_VAR == 4) && rep_ == 1), pvC = (PROBE_DUP == 3 && PROBE_VAR == 4 && rep_ == 1);
        if (bx < 2 * BATCH * NH) {
            constexpr int SLOT = 12544, DEPTH = 8;
            const int d = bx >> 6, b = (bx >> 3) & 7, h = bx & 7;
            const unsigned char* rbase = recbase(P_ws, P_outb, b) + ((size_t)h * 2 + d) * REC_BYTES;
            const unsigned char* vbase = P_ws + WS_VD + (((size_t)b * 144) * 8 + h) * 2048;
#define RB_SC(step_) (d == 0 ? (step_) : ((step_) < 16 ? 15 - (step_) : 159 - (step_)))
#define RB_BAR() do { asm volatile("" ::: "memory"); __builtin_amdgcn_s_barrier(); asm volatile("" ::: "memory"); } while (0)
            if (wave >= 4) {
                const int w = wave - 4;
#define RB_ISSUE(step_) do { const int sc_ = RB_SC(step_); LAS unsigned char* sl_ = lds + ((step_) & (DEPTH - 1)) * SLOT; \
                    const unsigned char* rec_ = rbase + (size_t)sc_ * (16 * REC_BYTES); const unsigned char* vd_ = vbase + (size_t)sc_ * (8 * 2048); \
                    _Pragma("unroll") for (int q_ = 0; q_ < 3; ++q_) { const int id_ = w + 4 * q_; \
                        const unsigned char* src_ = (id_ < 10) ? rec_ + id_ * 1024 : vd_ + (id_ - 10) * 1024; \
                        LAS unsigned char* dst_ = sl_ + ((id_ < 10) ? id_ * 1024 : 10496 + (id_ - 10) * 1024); \
                        __builtin_amdgcn_global_load_lds((const unsigned*)(src_ + lane * 16), (LAS unsigned*)dst_, 16, 0, 0); } \
                    if (w == 0) __builtin_amdgcn_global_load_lds((const unsigned*)(rec_ + 10240 + lane * 4), (LAS unsigned*)(sl_ + 10240), 4, 0, 0); } while (0)
#define RB_WAIT6() do { if (w == 0) asm volatile("s_waitcnt vmcnt(20)" ::: "memory"); else asm volatile("s_waitcnt vmcnt(15)" ::: "memory"); } while (0)
                if (!pvB) { for (int s = 0; s < DEPTH - 1; ++s) RB_ISSUE(s);
                RB_WAIT6(); }
                RB_BAR();
                for (int s = 0; s < 144; ++s) {
                    if (!pvB) { if (s + DEPTH - 1 < 144) { RB_ISSUE(s + DEPTH - 1); RB_WAIT6(); }
                    else asm volatile("s_waitcnt vmcnt(0)" ::: "memory"); }
                    if (!pvC) RB_BAR();
                }
#undef RB_ISSUE
#undef RB_WAIT6
            } else {
                const int it = wave, g = lane >> 4, c = lane & 15;
                bf16* Yb = (bf16*)(P_ws + (d ? WS_Y1 : WS_Y0));
                f32x4 ST[4];
#pragma unroll
                for (int jt = 0; jt < 4; ++jt) ST[jt] = (f32x4){0.f, 0.f, 0.f, 0.f};
                const f32x4 z4 = (f32x4){0.f, 0.f, 0.f, 0.f};
#define BX8(v) __builtin_bit_cast(pg8::bf16x8, v)
                RB_BAR();
                v4u nQ0, nQ1, nP0, nP1, nK0, nK1, nK2, nK3, nMA, nMB; f32x4 nG0, nG1, nG2, nG3; v2u nV;
#define RB_LDS(step_) do { const LAS unsigned char* sl_ = lds + ((step_) & (DEPTH - 1)) * SLOT; \
                    nQ0 = *(const LAS v4u*)(sl_ + lane * 16); nQ1 = *(const LAS v4u*)(sl_ + 1024 + lane * 16); nP0 = *(const LAS v4u*)(sl_ + 2048 + lane * 16); nP1 = *(const LAS v4u*)(sl_ + 3072 + lane * 16); \
                    nK0 = *(const LAS v4u*)(sl_ + 4096 + lane * 16); nK1 = *(const LAS v4u*)(sl_ + 5120 + lane * 16); nK2 = *(const LAS v4u*)(sl_ + 6144 + lane * 16); nK3 = *(const LAS v4u*)(sl_ + 7168 + lane * 16); \
                    nMA = *(const LAS v4u*)(sl_ + 8192 + lane * 16); nMB = *(const LAS v4u*)(sl_ + 9216 + lane * 16); \
                    nG0 = *(const LAS f32x4*)(sl_ + 10240 + 16 * g); nG1 = *(const LAS f32x4*)(sl_ + 10240 + 64 + 16 * g); nG2 = *(const LAS f32x4*)(sl_ + 10240 + 128 + 16 * g); nG3 = *(const LAS f32x4*)(sl_ + 10240 + 192 + 16 * g); \
                    nV = *(const LAS v2u*)(sl_ + 10496 + it * 512 + lane * 8); } while (0)
                RB_LDS(0);
                for (int step = 0; step < 144; ++step) {
                    const int sc = RB_SC(step);
                    if (pvA) { RB_BAR(); continue; }
                    const v4u Q0 = nQ0, Q1 = nQ1, P0 = nP0, P1 = nP1, K0 = nK0, K1 = nK1, K2 = nK2, K3 = nK3, MA = nMA, MB = nMB; const f32x4 G0 = nG0, G1 = nG1, G2 = nG2, G3 = nG3; const v2u Vd = nV;
                    if (step + 1 < 144) RB_LDS(step + 1);
                    const v4u bs0 = (v4u){pg8::cvt_pk_bf16(ST[0][0], ST[0][1]), pg8::cvt_pk_bf16(ST[0][2], ST[0][3]), pg8::cvt_pk_bf16(ST[1][0], ST[1][1]), pg8::cvt_pk_bf16(ST[1][2], ST[1][3])};
                    const v4u bs1 = (v4u){pg8::cvt_pk_bf16(ST[2][0], ST[2][1]), pg8::cvt_pk_bf16(ST[2][2], ST[2][3]), pg8::cvt_pk_bf16(ST[3][0], ST[3][1]), pg8::cvt_pk_bf16(ST[3][2], ST[3][3])};
                    f32x4 X = __builtin_amdgcn_mfma_f32_16x16x32_bf16(BX8(Q0), BX8(bs0), z4, 0, 0, 0);
                    X = __builtin_amdgcn_mfma_f32_16x16x32_bf16(BX8(Q1), BX8(bs1), X, 0, 0, 0);
                    X = __builtin_amdgcn_mfma_f32_16x16x32_bf16(BX8(((v4u){MA.x, MA.y, 0u, 0u})), BX8(((v4u){Vd.x, Vd.y, 0u, 0u})), X, 0, 0, 0);
                    const f32x4 U = __builtin_amdgcn_mfma_f32_16x16x32_bf16(BX8(((v4u){MA.z, MA.w, 0u, 0u})), BX8(((v4u){pg8::cvt_pk_bf16(X[0], X[1]), pg8::cvt_pk_bf16(X[2], X[3]), 0u, 0u})), z4, 0, 0, 0);
                    const v4u vu = (v4u){Vd.x, Vd.y, pg8::cvt_pk_bf16(U[0], U[1]), pg8::cvt_pk_bf16(U[2], U[3])};
                    if (sc >= 16) {
                        f32x4 Y = __builtin_amdgcn_mfma_f32_16x16x32_bf16(BX8(P0), BX8(bs0), z4, 0, 0, 0);
                        Y = __builtin_amdgcn_mfma_f32_16x16x32_bf16(BX8(P1), BX8(bs1), Y, 0, 0, 0);
                        Y = __builtin_amdgcn_mfma_f32_16x16x32_bf16(BX8(MB), BX8(vu), Y, 0, 0, 0);
                        bf16* yp = Yb + (size_t)(b * SEQ + (sc - 16) * 16 + 4 * g) * CW + h * 64 + 16 * it + c;
                        if (!pvB) { const unsigned y01 = pg8::cvt_pk_bf16(Y[0], Y[1]), y23 = pg8::cvt_pk_bf16(Y[2], Y[3]); yp[0] = (bf16)y01; yp[CW] = (bf16)(y01 >> 16); yp[2 * CW] = (bf16)y23; yp[3 * CW] = (bf16)(y23 >> 16); } else asm volatile("" :: "v"(Y[0]), "v"(Y[1]), "v"(Y[2]), "v"(Y[3]));
                    }
                    ST[0] = __builtin_amdgcn_mfma_f32_16x16x32_bf16(BX8(K0), BX8(vu), G0 * ST[0], 0, 0, 0);
                    ST[1] = __builtin_amdgcn_mfma_f32_16x16x32_bf16(BX8(K1), BX8(vu), G1 * ST[1], 0, 0, 0);
                    ST[2] = __builtin_amdgcn_mfma_f32_16x16x32_bf16(BX8(K2), BX8(vu), G2 * ST[2], 0, 0, 0);
                    ST[3] = __builtin_amdgcn_mfma_f32_16x16x32_bf16(BX8(K3), BX8(vu), G3 * ST[3], 0, 0, 0);
                    if (!pvC) RB_BAR();
                }
#undef RB_LDS
            }
#undef RB_SC
#undef RB_BAR
        } else {
        {
            const int xw = (bx - 2 * BATCH * NH) * NWAVES + wave, XNW = (G - 2 * BATCH * NH) * NWAVES;
            for (int it = 8 * 32 + xw; it < 24 * 32; it += XNW) {
                const int cb = it >> 5, kc = it & 31, k0 = kc * 32, n0 = cb * 256 + lane * 4;
                float sb[9];
#pragma unroll
                for (int b = 0; b < 9; ++b) { const float cv = (b < 8) ? args.in[1][b * D + k0 + (lane & 31)] : args.in[3][k0 + (lane & 31)]; sb[b] = cv / (1.f + __expf(-cv)); }
                f32x4 acc[9];
#pragma unroll
                for (int b = 0; b < 9; ++b) acc[b] = (f32x4){0.f, 0.f, 0.f, 0.f};
#pragma unroll
                for (int kk = 0; kk < 32; ++kk) {
                    const f32x4 wv = *(const f32x4*)(args.in[4] + (size_t)(k0 + kk) * MODW + n0);
#pragma unroll
                    for (int b = 0; b < 9; ++b) { const float s = __builtin_bit_cast(float, __builtin_amdgcn_readlane(__builtin_bit_cast(int, sb[b]), kk)); acc[b] += wv * s; }
                }
#pragma unroll
                for (int b = 0; b < 9; ++b) { float* p = P_modb + b * MODW + n0; atomicAdd(p, acc[b].x); atomicAdd(p + 1, acc[b].y); atomicAdd(p + 2, acc[b].z); atomicAdd(p + 3, acc[b].w); }
            }
            LAS float* scr0 = (LAS float*)(lds + wave * 16384);
            bf16* WoutT = (bf16*)(P_ws + WS_WOUT);
            for (int it = xw; it < (D / 64) * (D / 32); it += XNW) transpose_item(args.in[21], D, D, WoutT, 0, scr0, it, lane);
        }
        {
            const float* const P_w_up = TABP(22);
            const float* const P_w_down = TABP(25);
            LAS float* scr = (LAS float*)(lds + wave * 16384);
            bf16* WupT = (bf16*)(P_ws + WS_WUP); bf16* WdnT = (bf16*)(P_ws + WS_WDN);
            constexpr int I_UP = (D / 64) * (F2 / 32), I_DN = (DFF / 64) * (D / 32);
            (void)P_w_down; (void)WdnT; (void)I_DN;
            for (int it = (bx - 2 * BATCH * NH) * NWAVES + wave; it < I_UP; it += (G - 2 * BATCH * NH) * NWAVES) transpose_item(P_w_up, D, F2, WupT, 0, scr, it, lane);
        }
        {
        const float* const P_fourier_g = TABP(20);
        bf16* FN = (bf16*)(P_ws + WS_FN);
        const bf16* Yf = (const bf16*)(P_outb + OUT_YF); const float* ALT = (const float*)(P_ws + WS_ALT);
        for (int row = (bx - 2 * BATCH * NH) * NWAVES + wave; row < MLAT; row += (G - 2 * BATCH * NH) * NWAVES) {
            const int b = row >> 11, k = row & (SEQ - 1), kk = k <= 1024 ? k : 2048 - k;
            float v0, v1, v2, v3, v4, v5, v6, v7;
            if (k == 1024) { const float* ap = ALT + b * 512 + lane * 8; const float s_ = 0.00276213586400995f;
                v0 = ap[0] * s_; v1 = ap[1] * s_; v2 = ap[2] * s_; v3 = ap[3] * s_; v4 = ap[4] * s_; v5 = ap[5] * s_; v6 = ap[6] * s_; v7 = ap[7] * s_; }
            else {
                const bf16* yc = Yf + (size_t)kk * 4096 + b * 512 + lane * 8; const size_t PS = (size_t)2048 * 4096, SS = (size_t)1024 * 4096;
                const v4u c0 = *(const v4u*)yc, c1 = *(const v4u*)(yc + PS), s0 = *(const v4u*)(yc + SS), s1 = *(const v4u*)(yc + SS + PS);
                const float sg = (k == 0) ? 0.f : (k < 1024 ? -1.f : 1.f);
                v0 = (bflo(c0.x) + bflo(c1.x)) + sg * (bflo(s0.x) + bflo(s1.x)); v1 = (bfhi(c0.x) + bfhi(c1.x)) + sg * (bfhi(s0.x) + bfhi(s1.x));
                v2 = (bflo(c0.y) + bflo(c1.y)) + sg * (bflo(s0.y) + bflo(s1.y)); v3 = (bfhi(c0.y) + bfhi(c1.y)) + sg * (bfhi(s0.y) + bfhi(s1.y));
                v4 = (bflo(c0.z) + bflo(c1.z)) + sg * (bflo(s0.z) + bflo(s1.z)); v5 = (bfhi(c0.z) + bfhi(c1.z)) + sg * (bfhi(s0.z) + bfhi(s1.z));
                v6 = (bflo(c0.w) + bflo(c1.w)) + sg * (bflo(s0.w) + bflo(s1.w)); v7 = (bfhi(c0.w) + bfhi(c1.w)) + sg * (bfhi(s0.w) + bfhi(s1.w));
            }
            const float ss = wave_sum((v0 * v0 + v1 * v1) + (v2 * v2 + v3 * v3) + (v4 * v4 + v5 * v5) + (v6 * v6 + v7 * v7));
            const float rstd = 1.f / sqrtf(ss * (1.f / 512.f) + 1e-6f);
            const f32x4 g0 = *(const f32x4*)(P_fourier_g + lane * 8), g1 = *(const f32x4*)(P_fourier_g + lane * 8 + 4);
            v4u o; o.x = pk2(v0 * rstd * g0.x, v1 * rstd * g0.y); o.y = pk2(v2 * rstd * g0.z, v3 * rstd * g0.w);
            o.z = pk2(v4 * rstd * g1.x, v5 * rstd * g1.y); o.w = pk2(v6 * rstd * g1.z, v7 * rstd * g1.w);
            *(v4u*)(FN + (size_t)row * FW + lane * 8) = o;
        }
        }
        }
    }
    GRID_BAR();

    REPS(4)
    {
        PHASE_VARS
        const float* const P_gn_g = TABP(18);
        const float* const P_gn_b = TABP(19);
        const float* const P_fourier_g = TABP(20);
        const int g = lane >> 4, n = lane & 15, h = wave;
        const bf16* G2T = (const bf16*)(P_ws + WS_G2T); const bf16* SG = (const bf16*)(P_outb + OUT_SGD);
        const bf16* Y0 = (const bf16*)(P_ws + WS_Y0); const bf16* Y1 = (const bf16*)(P_ws + WS_Y1);
        const float* CF = (const float*)(P_outb + OUT_COEF);
        bf16* AR = (bf16*)(P_ws + WS_AR);
        pg8::bf16x8 gw_[4][4];
#pragma unroll
        for (int ks = 0; ks < 4; ++ks)
#pragma unroll
            for (int ct = 0; ct < 4; ++ct) gw_[ks][ct] = *(const pg8::bf16x8*)(G2T + (size_t)(h * 64 + 16 * ct + n) * 128 + 32 * ks + 8 * g);
        for (int ci0 = bx; ci0 < BATCH * 128; ci0 += 2 * G) {
            pg8::bf16x8 sg_[2][4]; v2u ya_[2][4], yb_[2][4]; float cf_[2]; unsigned vv_[2][16]; int rowS[2]; bool val_[2];
#pragma unroll
            for (int s_ = 0; s_ < 2; ++s_) {
                const int cix = ci0 + s_ * G; val_[s_] = cix < BATCH * 128; const int ci = val_[s_] ? cix : ci0;
                const int b = ci >> 7, lc = ci & 127, sc = lc + 16, row = b * SEQ + lc * 16 + n; rowS[s_] = row;
#pragma unroll
                for (int ks = 0; ks < 4; ++ks) sg_[s_][ks] = *(const pg8::bf16x8*)(SG + (size_t)row * 128 + 32 * ks + 8 * g);
#pragma unroll
                for (int ct = 0; ct < 4; ++ct) { const size_t o = (size_t)row * CW + h * 64 + 16 * ct + 4 * g; ya_[s_][ct] = *(const v2u*)(Y0 + o); yb_[s_][ct] = *(const v2u*)(Y1 + o); }
                cf_[s_] = CF[(size_t)row * 8 + h];
                const unsigned short* vd = (const unsigned short*)(P_ws + WS_VD + (((size_t)(b * 144 + sc)) * 8 + h) * 2048);
#pragma unroll
                for (int ct = 0; ct < 4; ++ct)
#pragma unroll
                    for (int e = 0; e < 4; ++e) vv_[s_][ct * 4 + e] = vd[ct * 256 + (16 * (n >> 2) + 4 * g + e) * 4 + (n & 3)];
            }
#pragma unroll
            for (int s_ = 0; s_ < 2; ++s_) {
                const int row = rowS[s_];
                f32x4 gt[4];
#pragma unroll
                for (int ct = 0; ct < 4; ++ct) gt[ct] = (f32x4){0.f, 0.f, 0.f, 0.f};
#pragma unroll
                for (int ks = 0; ks < 4; ++ks)
#pragma unroll
                    for (int ct = 0; ct < 4; ++ct) gt[ct] = __builtin_amdgcn_mfma_f32_16x16x32_bf16(gw_[ks][ct], sg_[s_][ks], gt[ct], 0, 0, 0);
                f32x4 y[4]; float s = 0.f;
#pragma unroll
                for (int ct = 0; ct < 4; ++ct) { const v2u a_ = ya_[s_][ct], b_ = yb_[s_][ct]; y[ct] = (f32x4){bflo(a_.x) + bflo(b_.x), bfhi(a_.x) + bfhi(b_.x), bflo(a_.y) + bflo(b_.y), bfhi(a_.y) + bfhi(b_.y)}; s += (y[ct].x + y[ct].y) + (y[ct].z + y[ct].w); }
                s += __shfl_xor(s, 16); s += __shfl_xor(s, 32);
                const float mu = s * (1.f / 64.f); float q = 0.f;
#pragma unroll
                for (int ct = 0; ct < 4; ++ct) { y[ct] = y[ct] - mu; q += (y[ct].x * y[ct].x + y[ct].y * y[ct].y) + (y[ct].z * y[ct].z + y[ct].w * y[ct].w); }
                q += __shfl_xor(q, 16); q += __shfl_xor(q, 32);
                const float rstd = 1.f / sqrtf(q * (1.f / 64.f) + 64e-5f), cf = cf_[s_];
#pragma unroll
                for (int ct = 0; ct < 4; ++ct) {
                    const int cb = h * 64 + 16 * ct + 4 * g; const f32x4 gg = *(const f32x4*)(P_gn_g + cb), gb = *(const f32x4*)(P_gn_b + cb);
                    float o[4];
#pragma unroll
                    for (int e = 0; e < 4; ++e) { const float vv = bf2f((unsigned short)vv_[s_][ct * 4 + e]);
                        o[e] = (y[ct][e] * rstd * gg[e] + gb[e] + cf * vv) * gt[ct][e]; }
                    if (val_[s_]) *(v2u*)(AR + (size_t)row * CW + cb) = (v2u){pk2(o[0], o[1]), pk2(o[2], o[3])};
                }
            }
        }
    }
    GRID_BAR();

    REPS(12)
    {
        PHASE_VARS
        const float* const P_x = TABP(0);
        const float* const P_ada_b = TABP(5);
        const float* const P_w_out = TABP(21);
        pg8::Gemm g{(const bf16*)(P_ws + WS_FN), (const bf16*)(P_ws + WS_WOUT), MLAT, D, D, FW, D, 8, (long)WS_AR - (long)WS_FN - 8 * 128};
        pg8::StaticOrder S; S.init(MLAT, D, G, bx);
        const float* const P_norm2_g = TABP(7);
        pg8::RowSumSq st{(unsigned*)(P_ws + WS_XBUF), ctl + CW_SEAM};
        pg8::EpiResNormMod E{P_x, P_outp, (bf16*)(P_ws + WS_H2), P_modb, P_ada_b, P_norm2_g, 2 * D, 3 * D, 4 * D, st};
        pg8::gemm_phase<pg8::EpiResNormMod, pg8::StaticOrder, false, true>(lds, g, S, E);
    }
    GRID_BAR();

    for (int half = 0; half < 2; ++half) {
        const float* const P_w_up = TABP(22);
        const float* const P_fconv_w = TABP(23);
        const float* const P_fconv_b = TABP(24);
        REPS(13)
        {
            PHASE_VARS
            pg8::Gemm g{(const bf16*)(P_ws + WS_H2) + (size_t)half * 8192 * D, (const bf16*)(P_ws + WS_WUP), 8192, F2, D, D, D, 0, 0}; pg8::StaticOrder S; S.init(8192, F2, G, bx);
            pg8::EpiBf16 E{(bf16*)(P_ws + WS_U2), F2, PROBE_DUP == 13 && PROBE_VAR == 1 && rep_ == 1};
            pg8::gemm_phase<pg8::EpiBf16, pg8::StaticOrder, true, true>(lds, g, S, E);
            if (half == 0 && rep_ == 0) {
                const float* const P_w_down = TABP(25);
                const int nwg_ = (8192 / pg8::BM) * (F2 / pg8::BM), most_ = (nwg_ + G - 1) / G, n_full = nwg_ - (most_ - 1) * G, n_idle = G - n_full;
                const int first_ = n_idle > 0 ? n_full : 0, cnt_ = n_idle > 0 ? n_idle : G;
                if (bx >= first_) {
                    LAS float* scr = (LAS float*)(lds + wave * 16384); bf16* WdnT = (bf16*)(P_ws + WS_WDN);
                    for (int it = (bx - first_) * NWAVES + wave; it < (DFF / 64) * (D / 32); it += cnt_ * NWAVES) transpose_item(P_w_down, DFF, D, WdnT, 0, scr, it, lane);
                }
            }
        }
        GRID_BAR();
        REPS(5)
        {
            PHASE_VARS
            const float* const P_fconv_w = TABP(23);
            const float* const P_fconv_b = TABP(24);
            const bf16* U2 = (const bf16*)(P_ws + WS_U2); bf16* ACT = (bf16*)(P_ws + WS_ACT) + (size_t)half * 8192 * DFF;
            const int xcd = bx & 7, widx = (bx >> 3) * NWAVES + wave, nwx = (G >> 3) * NWAVES;
            for (int j = widx; j < 704; j += nwx) {
                int ln = lane; asm volatile("" : "+v"(ln));
                const int jj = 704 * xcd + j, comb = jj >> 7, r1 = jj & 127, seg = r1 & 7, gp = r1 >> 3, bl = comb / 11, fg = comb - bl * 11;
                const int f = fg * 256 + ln * 4, gc0 = seg * 8, gr = gp * 2;
                f32x4 wg[9], wv[9];
#pragma unroll
                for (int k = 0; k < 9; ++k) { wg[k] = *(const f32x4*)(P_fconv_w + (size_t)k * F2 + f); wv[k] = *(const f32x4*)(P_fconv_w + (size_t)k * F2 + DFF + f); }
                const f32x4 bg = *(const f32x4*)(P_fconv_b + f), bv = *(const f32x4*)(P_fconv_b + DFF + f);
                const int ra = gr > 0 ? gr - 1 : gr, rd = gr + 2 < 32 ? gr + 2 : gr + 1; const unsigned mra = gr > 0 ? 0xffffffffu : 0u, mrd = gr + 2 < 32 ? 0xffffffffu : 0u;
                const bf16* ub = U2 + (size_t)(bl * SEQ) * F2 + f;
                v2u cg[3][4], cv[3][4];
#define P7_LOADCOL(slot, gc) do { const int gcc = (gc) < 0 ? 0 : ((gc) > 63 ? 63 : (gc)); const unsigned mc = ((gc) < 0 || (gc) > 63) ? 0u : 0xffffffffu; \
                    const bf16* pa = ub + (size_t)(ra * 64 + gcc) * F2; const bf16* pb = ub + (size_t)(gr * 64 + gcc) * F2; const bf16* pc = pb + (size_t)64 * F2; const bf16* pd = ub + (size_t)(rd * 64 + gcc) * F2; \
                    v2u a0 = *(const v2u*)pa, a1 = *(const v2u*)pb, a2 = *(const v2u*)pc, a3 = *(const v2u*)pd, d0 = *(const v2u*)(pa + DFF), d1 = *(const v2u*)(pb + DFF), d2 = *(const v2u*)(pc + DFF), d3 = *(const v2u*)(pd + DFF); \
                    const unsigned ma_ = mc & mra, md_ = mc & mrd; \
                    cg[slot][0] = (v2u){a0.x & ma_, a0.y & ma_}; cg[slot][1] = (v2u){a1.x & mc, a1.y & mc}; cg[slot][2] = (v2u){a2.x & mc, a2.y & mc}; cg[slot][3] = (v2u){a3.x & md_, a3.y & md_}; \
                    cv[slot][0] = (v2u){d0.x & ma_, d0.y & ma_}; cv[slot][1] = (v2u){d1.x & mc, d1.y & mc}; cv[slot][2] = (v2u){d2.x & mc, d2.y & mc}; cv[slot][3] = (v2u){d3.x & md_, d3.y & md_}; } while (0)
                P7_LOADCOL(0, gc0 - 1); P7_LOADCOL(1, gc0);
#pragma unroll
                for (int j = 0; j < 8; ++j) {
                    P7_LOADCOL((j + 2) % 3, gc0 + j + 1);
#pragma unroll
                    for (int orow = 0; orow < 2; ++orow) {
                        f32x4 ga = bg, va = bv;
#pragma unroll
                        for (int dc = 0; dc < 3; ++dc) { const int sl = (j + dc) % 3;
#pragma unroll
                            for (int dr = 0; dr < 3; ++dr) { const v2u xg = cg[sl][orow + dr], xv = cv[sl][orow + dr]; const int k = dr * 3 + dc;
                                ga += wg[k] * (f32x4){bflo(xg.x), bfhi(xg.x), bflo(xg.y), bfhi(xg.y)};
                                va += wv[k] * (f32x4){bflo(xv.x), bfhi(xv.x), bflo(xv.y), bfhi(xv.y)}; } }
                        float r[4];
#pragma unroll
                        for (int q = 0; q < 4; ++q) r[q] = ga[q] * sigm_fast(ga[q]) * va[q];
                        *(v2u*)(ACT + (size_t)(bl * SEQ + (gr + orow) * 64 + gc0 + j) * DFF + f) = (v2u){pg8::cvt_pk_bf16(r[0], r[1]), pg8::cvt_pk_bf16(r[2], r[3])};
                    }
                }
#undef P7_LOADCOL
            }
        }
        GRID_BAR();
    }

    {
        PHASE_VARS
        const float* const P_ada_b = TABP(5);
        const float* const P_w_down = TABP(25);
        pg8::Gemm g{(const bf16*)(P_ws + WS_ACT), (const bf16*)(P_ws + WS_WDN), MLAT, D, DFF, DFF, DFF, 0, 0}; pg8::StaticOrder S; S.init(MLAT, D, G, bx);
        const float* const P_final_g = TABP(26);
        pg8::RowSumSq st{(unsigned*)(P_ws + WS_XBUF + 262144), ctl + CW_SEAM + SEAM_BANK};
        pg8::EpiResNorm E{P_outp, P_outp, P_modb, P_ada_b, P_final_g, 5 * D, st};
        pg8::gemm_phase<pg8::EpiResNorm, pg8::StaticOrder, false, true>(lds, g, S, E);
    }

}

extern "C" void kernel_launch(void* const* d_in, const int* in_sizes, int n_in, void* d_out, int out_size, void* d_ws, size_t ws_size, hipStream_t stream) {
    static int grid = 0;
    if (grid == 0) {
        if (n_in != 27 || out_size != MLAT * D || ws_size < WS_END) { fprintf(stderr, "kernel_launch: unexpected sizes n_in %d out %d ws %zu\n", n_in, out_size, ws_size); grid = -1; return; }
        int dev = 0, cus = 0, per_cu = 0;
        if (hipGetDevice(&dev) != hipSuccess || hipDeviceGetAttribute(&cus, hipDeviceAttributeMultiprocessorCount, dev) != hipSuccess) { grid = -1; return; }
        if (hipFuncSetAttribute((const void*)fwd_kernel, hipFuncAttributeMaxDynamicSharedMemorySize, LDS_BYTES) != hipSuccess) { fprintf(stderr, "kernel_launch: hipFuncSetAttribute failed\n"); grid = -1; return; }
        if (hipOccupancyMaxActiveBlocksPerMultiprocessor(&per_cu, (const void*)fwd_kernel, NWAVES * 64, LDS_BYTES) != hipSuccess || per_cu < 1) { fprintf(stderr, "kernel_launch: occupancy query says %d\n", per_cu); }
        (void)hipGetLastError();
        grid = cus;
    }
    if (grid < 0) return;
    if (hipMemsetAsync((char*)d_ws + WS_CTL, 0, CTL_ZERO_BYTES, stream) != hipSuccess) { fprintf(stderr, "kernel_launch: memset failed\n"); return; }
    Args a{};
    for (int i = 0; i < 27; ++i) a.in[i] = (const float*)d_in[i];
    a.out = (float*)d_out; a.ws = (unsigned char*)d_ws;
    void* kargs[] = {&a};
    hipError_t e = hipLaunchCooperativeKernel((const void*)fwd_kernel, dim3(grid), dim3(NWAVES * 64), kargs, LDS_BYTES, stream);
    if (e != hipSuccess) fprintf(stderr, "kernel_launch: cooperative launch failed: %s (grid %d)\n", hipGetErrorString(e), grid);
}
```

```cpp
#include <hip/hip_runtime.h>
#include <cstdio>
#include <cstdint>
#ifndef PROBE_DUP
#define PROBE_DUP 0
#endif
#ifndef PROBE_VAR
#define PROBE_VAR 0
#endif
#define REPS(k) for (int rep_ = 0; rep_ < ((PROBE_DUP == (k)) ? 2 : 1); ++rep_)

namespace pg8 {
#define PG8_LAS __attribute__((address_space(3)))
typedef unsigned short bf16_t;
typedef short bf16x8 __attribute__((ext_vector_type(8)));
typedef float f32x4 __attribute__((ext_vector_type(4)));
typedef unsigned u32x4 __attribute__((ext_vector_type(4)));
constexpr int BM = 256, BK = 64, HALF = 128, HTB = HALF * BK * 2, STAGE_BYTES = 8 * HTB, NXCD = 8, WGM = 8;

__host__ __device__ __forceinline__ int lds_byte(int r, int c) { const int st = (r >> 4) * 2 + (c >> 5), rr = r & 15, cc = c & 31, ob = rr * 64 + cc * 2; return st * 1024 + (ob ^ (((ob >> 9) & 1) << 5)); }
__host__ __device__ __forceinline__ void stage_rc(int b, int& R, int& C) { const int st = b / 1024, sb = b % 1024, swz = sb ^ (((sb >> 9) & 1) << 5); R = (st >> 1) * 16 + swz / 64; C = (st & 1) * 32 + (swz % 64) / 2; }
__host__ __device__ __forceinline__ int perm32(int rho) { const int n = rho >> 4, i = rho & 15; return 8 * (i >> 2) + 4 * n + (i & 3); }

struct Unit { int pm, pn, aux; };
struct Gemm { const bf16_t* A; const bf16_t* Bt; int M, N, K, lda, ldb; int ksplit; long adelta; };

struct StaticOrder {
    int nM, nN, nwg, G, c;
    __host__ __device__ void init(int M, int N, int G_, int c_) { nM = M / BM; nN = N / BM; nwg = nM * nN; G = G_; c = c_; }
    __host__ __device__ bool next(int i, Unit& u) const {
        const long L = (long)i * G + c; if (L >= nwg) return false;
        int wgid = (int)L; { const int q = nwg / NXCD, r = nwg % NXCD, xcd = wgid % NXCD, off = wgid / NXCD; wgid = (xcd < r ? xcd * (q + 1) : r * (q + 1) + (xcd - r) * q) + off; }
        const int nig = WGM * nN, gid = wgid / nig, fm = gid * WGM, gsz = (nM - fm) < WGM ? (nM - fm) : WGM;
        u.pm = fm + ((wgid % nig) % gsz); u.pn = (wgid % nig) / gsz; u.aux = 0; return true;
    }
    __device__ __forceinline__ const char* aptr(const Gemm& g, const Unit& u) const { return (const char*)g.A + (size_t)u.pm * BM * g.lda * 2; }
    __device__ __forceinline__ const char* bptr(const Gemm& g, const Unit& u) const { return (const char*)g.Bt + (size_t)u.pn * BM * g.ldb * 2; }
    __device__ __forceinline__ void a_ready(const Unit&) const {}
    __device__ __forceinline__ void done(const Unit&) const {}
};
struct DftOrder {
    int G, c;
    __device__ bool next(int i, Unit& u) const { const int L = i * G + c; if (L >= 256) return false; u.aux = L >> 7; const int r = L & 127; u.pn = r & 15; u.pm = r >> 4; return true; }
    __device__ __forceinline__ const char* aptr(const Gemm& g, const Unit& u) const { return (const char*)g.A + ((size_t)u.pm * BM * g.lda + (size_t)u.aux * 1024) * 2; }
    __device__ __forceinline__ const char* bptr(const Gemm& g, const Unit& u) const { return (const char*)g.Bt + ((size_t)u.pn * BM * g.ldb + (u.pm >= 4 ? 2048 : 0) + (size_t)u.aux * 1024) * 2; }
    __device__ __forceinline__ void a_ready(const Unit&) const {}
    __device__ __forceinline__ void done(const Unit&) const {}
};

typedef __bf16 bf2_t __attribute__((ext_vector_type(2)));
typedef float f2_t __attribute__((ext_vector_type(2)));
__device__ __forceinline__ unsigned cvt_pk_bf16(float lo, float hi) { const f2_t f = {lo, hi}; const bf2_t b = __builtin_convertvector(f, bf2_t); return __builtin_bit_cast(unsigned, b); }

struct EpiBf16 {
    static constexpr bool PERM = true, AFTER_DRAIN = false;
    bf16_t* O; int ldc; bool skip; const unsigned* gate; unsigned need;
    __device__ __forceinline__ void operator()(const f32x4 (&acc)[2][2][4][2], const Unit& u, int wr, int wc, int fr, int fq) const {
        const int row0 = u.pm * BM + wr * 64 + fr; const int col0 = u.pn * BM + wc * 32 + 8 * fq;
        if (need) { unsigned spins_ = 0; while (__hip_atomic_load(gate, __ATOMIC_RELAXED, __HIP_MEMORY_SCOPE_AGENT) < need) { __builtin_amdgcn_s_sleep(4); if (++spins_ > (1u << 22)) break; } }
        if (skip) { if (acc[0][0][0][0][0] == 12345.678f) O[0] = 1; return; }
#pragma unroll
        for (int ai = 0; ai < 2; ++ai)
#pragma unroll
            for (int m = 0; m < 4; ++m) { bf16_t* rowp = O + (size_t)(row0 + ai * HALF + m * 16) * ldc + col0;
#pragma unroll
                for (int bj = 0; bj < 2; ++bj) { const f32x4 v0 = acc[ai][bj][m][0], v1 = acc[ai][bj][m][1];
                    u32x4 w; w.x = cvt_pk_bf16(v0[0], v0[1]); w.y = cvt_pk_bf16(v0[2], v0[3]); w.z = cvt_pk_bf16(v1[0], v1[1]); w.w = cvt_pk_bf16(v1[2], v1[3]);
                    *(u32x4*)(rowp + bj * HALF) = w; } }
    }
};
struct EpiU {
    static constexpr bool PERM = true, AFTER_DRAIN = false;
    bf16_t* Uf; bf16_t* Ur;
    __device__ __forceinline__ void operator()(const f32x4 (&acc)[2][2][4][2], const Unit& u, int wr, int wc, int fr, int fq) const {
        bf16_t* base; int ldc, colt;
        if (u.pn < 2) { if (u.pm >= 64) return; base = Uf; ldc = 512; colt = u.pn * BM; } else { base = Ur; ldc = 2048; colt = (u.pn - 2) * BM; }
        const int row0 = u.pm * BM + wr * 64 + fr; const int col0 = colt + wc * 32 + 8 * fq;
#pragma unroll
        for (int ai = 0; ai < 2; ++ai)
#pragma unroll
            for (int m = 0; m < 4; ++m) { bf16_t* rowp = base + (size_t)(row0 + ai * HALF + m * 16) * ldc + col0;
#pragma unroll
                for (int bj = 0; bj < 2; ++bj) { const f32x4 v0 = acc[ai][bj][m][0], v1 = acc[ai][bj][m][1];
                    u32x4 w; w.x = cvt_pk_bf16(v0[0], v0[1]); w.y = cvt_pk_bf16(v0[2], v0[3]); w.z = cvt_pk_bf16(v1[0], v1[1]); w.w = cvt_pk_bf16(v1[2], v1[3]);
                    *(u32x4*)(rowp + bj * HALF) = w; } }
    }
};
struct EpiYpart {
    static constexpr bool PERM = true, AFTER_DRAIN = false;
    bf16_t* O;
    __device__ __forceinline__ void operator()(const f32x4 (&acc)[2][2][4][2], const Unit& u, int wr, int wc, int fr, int fq) const {
        const int row0 = u.pm * BM + wr * 64 + fr; const int col0 = u.pn * BM + wc * 32 + 8 * fq; bf16_t* base = O + (size_t)u.aux * 2048 * 4096;
#pragma unroll
        for (int ai = 0; ai < 2; ++ai)
#pragma unroll
            for (int m = 0; m < 4; ++m) { bf16_t* rowp = base + (size_t)(row0 + ai * HALF + m * 16) * 4096 + col0;
#pragma unroll
                for (int bj = 0; bj < 2; ++bj) { const f32x4 v0 = acc[ai][bj][m][0], v1 = acc[ai][bj][m][1];
                    u32x4 w; w.x = cvt_pk_bf16(v0[0], v0[1]); w.y = cvt_pk_bf16(v0[2], v0[3]); w.z = cvt_pk_bf16(v1[0], v1[1]); w.w = cvt_pk_bf16(v1[2], v1[3]);
                    *(u32x4*)(rowp + bj * HALF) = w; } }
    }
};
struct EpiF32 {
    static constexpr bool PERM = false, AFTER_DRAIN = false;
    float* C; int ldc;
    __device__ __forceinline__ void operator()(const f32x4 (&acc)[2][2][4][2], const Unit& u, int wr, int wc, int fr, int fq) const {
        const int row0 = u.pm * BM + wr * 64 + fr, col0 = u.pn * BM + wc * 32 + 4 * fq;
#pragma unroll
        for (int ai = 0; ai < 2; ++ai)
#pragma unroll
            for (int m = 0; m < 4; ++m) { float* rowp = C + (size_t)(row0 + ai * HALF + m * 16) * ldc + col0;
#pragma unroll
                for (int bj = 0; bj < 2; ++bj)
#pragma unroll
                    for (int n = 0; n < 2; ++n) *(f32x4*)(rowp + bj * HALF + n * 16) = acc[ai][bj][m][n]; }
    }
};
struct EpiResid {
    static constexpr bool PERM = false, AFTER_DRAIN = false;
    const float* base; float* out; int ldc; const float* modb; const float* adab;
    __device__ __forceinline__ void operator()(const f32x4 (&acc)[2][2][4][2], const Unit& u, int wr, int wc, int fr, int fq) const {
        const int row0 = u.pm * BM + wr * 64 + fr, col0 = u.pn * BM + wc * 32 + 4 * fq;
        const int b = (u.pm * BM) >> 11;
        f32x4 gv[2][2];
#pragma unroll
        for (int bj = 0; bj < 2; ++bj)
#pragma unroll
            for (int n = 0; n < 2; ++n) gv[bj][n] = *(const f32x4*)(modb + (size_t)b * 6144 + col0 + bj * HALF + n * 16) + *(const f32x4*)(adab + col0 + bj * HALF + n * 16);
#pragma unroll
        for (int ai = 0; ai < 2; ++ai)
#pragma unroll
            for (int m = 0; m < 4; ++m) { const size_t off = (size_t)(row0 + ai * HALF + m * 16) * ldc + col0;
#pragma unroll
                for (int bj = 0; bj < 2; ++bj)
#pragma unroll
                    for (int n = 0; n < 2; ++n) { const f32x4 bs = *(const f32x4*)(base + off + bj * HALF + n * 16);
                        *(f32x4*)(out + off + bj * HALF + n * 16) = bs + gv[bj][n] * acc[ai][bj][m][n]; } }
    }
};


struct RowSumSq {
    unsigned* xbuf;
    unsigned* cnt;
    __device__ __forceinline__ void run(const f32x4 (&v)[2][2][4][2], const Unit& u, int wr, int wc, int fr, int fq, PG8_LAS unsigned char* lds, int wid, int lane) const {
        PG8_LAS float* P = (PG8_LAS float*)lds;
        PG8_LAS float* S = (PG8_LAS float*)(lds + 4096);
#pragma unroll
        for (int ai = 0; ai < 2; ++ai)
#pragma unroll
            for (int m = 0; m < 4; ++m) {
                float s = 0.f;
#pragma unroll
                for (int bj = 0; bj < 2; ++bj)
#pragma unroll
                    for (int n = 0; n < 2; ++n) { const f32x4 x = v[ai][bj][m][n]; s += (x[0] * x[0] + x[1] * x[1]) + (x[2] * x[2] + x[3] * x[3]); }
                s += __shfl_xor(s, 16); s += __shfl_xor(s, 32);
                if (fq == 0) P[(ai * HALF + wr * 64 + m * 16 + fr) * 4 + wc] = s;
            }
        asm volatile("s_waitcnt lgkmcnt(0)" ::: "memory"); __builtin_amdgcn_s_barrier(); asm volatile("" ::: "memory");
        const int row = wid * 32 + (lane & 31);
        if (lane < 32) {
            const float t = (P[row * 4 + 0] + P[row * 4 + 1]) + (P[row * 4 + 2] + P[row * 4 + 3]);
            __hip_atomic_store(xbuf + ((size_t)(u.pm * BM + row) * 4 + u.pn), __builtin_bit_cast(unsigned, t), __ATOMIC_RELAXED, __HIP_MEMORY_SCOPE_AGENT);
        }
        asm volatile("s_waitcnt vmcnt(0)" ::: "memory");
        if (lane == 0) __hip_atomic_fetch_add(cnt + 64 * u.pm, 1u, __ATOMIC_RELAXED, __HIP_MEMORY_SCOPE_AGENT);
        if (wid == 0) {
            unsigned spins = 0;
            while ((unsigned)__builtin_amdgcn_readfirstlane(__hip_atomic_load(cnt + 64 * u.pm, __ATOMIC_RELAXED, __HIP_MEMORY_SCOPE_AGENT)) < 32u) { __builtin_amdgcn_s_sleep(2); if (++spins > (1u << 22)) break; }
            __builtin_amdgcn_fence(__ATOMIC_ACQUIRE, "agent");
        }
        asm volatile("s_waitcnt vmcnt(0) lgkmcnt(0)" ::: "memory"); __builtin_amdgcn_s_barrier(); asm volatile("" ::: "memory");
        if (lane < 32) {
            const unsigned* slot = xbuf + (size_t)(u.pm * BM + row) * 4; float t = 0.f;
#pragma unroll
            for (int q = 0; q < 4; ++q) t += __builtin_bit_cast(float, __hip_atomic_load(slot + q, __ATOMIC_RELAXED, __HIP_MEMORY_SCOPE_AGENT));
            S[row] = t;
        }
        asm volatile("s_waitcnt lgkmcnt(0)" ::: "memory"); __builtin_amdgcn_s_barrier(); asm volatile("" ::: "memory");
    }
};
struct EpiResNormMod {
    static constexpr bool PERM = false, AFTER_DRAIN = true;
    const float* base; float* out; bf16_t* H; const float* modb; const float* adab; const float* ng; int goff, shoff, scoff; RowSumSq st;
    __device__ __forceinline__ void fused(f32x4 (&acc)[2][2][4][2], const Unit& u, int wr, int wc, int fr, int fq, PG8_LAS unsigned char* lds, int wid, int lane) const {
        const int row0 = u.pm * BM + wr * 64 + fr, col0 = u.pn * BM + wc * 32 + 4 * fq; const int b = (u.pm * BM) >> 11;
        const float* mb = modb + (size_t)b * 6144;
#pragma unroll
        for (int bj = 0; bj < 2; ++bj)
#pragma unroll
            for (int n = 0; n < 2; ++n) { const int c = col0 + bj * HALF + n * 16; const f32x4 gv = *(const f32x4*)(mb + goff + c) + *(const f32x4*)(adab + goff + c);
#pragma unroll
                for (int ai = 0; ai < 2; ++ai)
#pragma unroll
                    for (int m = 0; m < 4; ++m) acc[ai][bj][m][n] *= gv; }
#pragma unroll
        for (int ai = 0; ai < 2; ++ai)
#pragma unroll
          for (int mp = 0; mp < 4; mp += 2) {
            f32x4 rv[2][2][2];
#pragma unroll
            for (int m = 0; m < 2; ++m)
#pragma unroll
                for (int bj = 0; bj < 2; ++bj)
#pragma unroll
                    for (int n = 0; n < 2; ++n) rv[m][bj][n] = *(const f32x4*)(base + (size_t)(row0 + ai * HALF + (mp + m) * 16) * 1024 + col0 + bj * HALF + n * 16);
#pragma unroll
            for (int m = 0; m < 2; ++m) { const size_t off = (size_t)(row0 + ai * HALF + (mp + m) * 16) * 1024 + col0;
#pragma unroll
                for (int bj = 0; bj < 2; ++bj)
#pragma unroll
                    for (int n = 0; n < 2; ++n) acc[ai][bj][mp + m][n] += rv[m][bj][n];
                {
                    char* xp = (char*)out + (off - col0) * 4 + (size_t)u.pn * 1024 + (wc * 4 + fq) * 32; const int mm = mp + m;
                    u32x4 w0, w1;
                    w0.x = cvt_pk_bf16(acc[ai][0][mm][0][0], acc[ai][0][mm][0][1]); w0.y = cvt_pk_bf16(acc[ai][0][mm][0][2], acc[ai][0][mm][0][3]); w0.z = cvt_pk_bf16(acc[ai][0][mm][1][0], acc[ai][0][mm][1][1]); w0.w = cvt_pk_bf16(acc[ai][0][mm][1][2], acc[ai][0][mm][1][3]);
                    w1.x = cvt_pk_bf16(acc[ai][1][mm][0][0], acc[ai][1][mm][0][1]); w1.y = cvt_pk_bf16(acc[ai][1][mm][0][2], acc[ai][1][mm][0][3]); w1.z = cvt_pk_bf16(acc[ai][1][mm][1][0], acc[ai][1][mm][1][1]); w1.w = cvt_pk_bf16(acc[ai][1][mm][1][2], acc[ai][1][mm][1][3]);
                    *(u32x4*)xp = w0; *(u32x4*)(xp + 16) = w1; }
                asm volatile("" : "+v"(acc[ai][0][mp + m][0]), "+v"(acc[ai][0][mp + m][1]), "+v"(acc[ai][1][mp + m][0]), "+v"(acc[ai][1][mp + m][1])); }
            asm volatile("" ::: "memory"); }
        st.run(acc, u, wr, wc, fr, fq, lds, wid, lane);
        const PG8_LAS float* S = (const PG8_LAS float*)(lds + 4096);
#pragma unroll
        for (int bj = 0; bj < 2; ++bj)
#pragma unroll
            for (int n = 0; n < 2; ++n) { const int c = col0 + bj * HALF + n * 16;
                const f32x4 g = *(const f32x4*)(ng + c), sc = *(const f32x4*)(mb + scoff + c) + *(const f32x4*)(adab + scoff + c) + 1.f, sh = *(const f32x4*)(mb + shoff + c) + *(const f32x4*)(adab + shoff + c);
                const f32x4 gs = g * sc;
#pragma unroll
                for (int ai = 0; ai < 2; ++ai)
#pragma unroll
                    for (int m = 0; m < 4; ++m) { const int r = ai * HALF + wr * 64 + m * 16 + fr; const float rstd = 1.f / sqrtf(S[r] * (1.f / 1024.f) + 1e-6f);
                        const f32x4 y = acc[ai][bj][m][n] * rstd * gs + sh;
                        unsigned w0 = cvt_pk_bf16(y[0], y[1]), w1 = cvt_pk_bf16(y[2], y[3]);
                        typedef unsigned u32x2 __attribute__((ext_vector_type(2)));
                        *(u32x2*)(H + (size_t)(u.pm * BM + r) * 1024 + c) = (u32x2){w0, w1}; } }
    }
};
struct EpiResNorm {
    static constexpr bool PERM = false, AFTER_DRAIN = true;
    const float* base; float* out; const float* modb; const float* adab; const float* fg; int goff; RowSumSq st;
    __device__ __forceinline__ void fused(f32x4 (&acc)[2][2][4][2], const Unit& u, int wr, int wc, int fr, int fq, PG8_LAS unsigned char* lds, int wid, int lane) const {
        const int row0 = u.pm * BM + wr * 64 + fr, col0 = u.pn * BM + wc * 32 + 4 * fq; const int b = (u.pm * BM) >> 11;
        const float* mb = modb + (size_t)b * 6144;
#pragma unroll
        for (int bj = 0; bj < 2; ++bj)
#pragma unroll
            for (int n = 0; n < 2; ++n) { const int c = col0 + bj * HALF + n * 16; const f32x4 gv = *(const f32x4*)(mb + goff + c) + *(const f32x4*)(adab + goff + c);
#pragma unroll
                for (int ai = 0; ai < 2; ++ai)
#pragma unroll
                    for (int m = 0; m < 4; ++m) acc[ai][bj][m][n] *= gv; }
#pragma unroll
        for (int ai = 0; ai < 2; ++ai)
#pragma unroll
          for (int mp = 0; mp < 4; mp += 2) {
            u32x4 rw[2][2];
#pragma unroll
            for (int m = 0; m < 2; ++m) { const char* xp = (const char*)base + (size_t)(row0 + ai * HALF + (mp + m) * 16) * 4096 + (size_t)u.pn * 1024 + (wc * 4 + fq) * 32;
                rw[m][0] = *(const u32x4*)xp; rw[m][1] = *(const u32x4*)(xp + 16); }
#pragma unroll
            for (int m = 0; m < 2; ++m) {
#pragma unroll
                for (int bj = 0; bj < 2; ++bj) { const u32x4 w = rw[m][bj];
                    acc[ai][bj][mp + m][0] += (f32x4){__builtin_bit_cast(float, w.x << 16), __builtin_bit_cast(float, w.x & 0xffff0000u), __builtin_bit_cast(float, w.y << 16), __builtin_bit_cast(float, w.y & 0xffff0000u)};
                    acc[ai][bj][mp + m][1] += (f32x4){__builtin_bit_cast(float, w.z << 16), __builtin_bit_cast(float, w.z & 0xffff0000u), __builtin_bit_cast(float, w.w << 16), __builtin_bit_cast(float, w.w & 0xffff0000u)}; }
                asm volatile("" : "+v"(acc[ai][0][mp + m][0]), "+v"(acc[ai][0][mp + m][1]), "+v"(acc[ai][1][mp + m][0]), "+v"(acc[ai][1][mp + m][1])); }
            asm volatile("" ::: "memory"); }
        st.run(acc, u, wr, wc, fr, fq, lds, wid, lane);
        const PG8_LAS float* S = (const PG8_LAS float*)(lds + 4096);
#pragma unroll
        for (int bj = 0; bj < 2; ++bj)
#pragma unroll
            for (int n = 0; n < 2; ++n) { const int c = col0 + bj * HALF + n * 16; const f32x4 g = *(const f32x4*)(fg + c);
#pragma unroll
                for (int ai = 0; ai < 2; ++ai)
#pragma unroll
                    for (int m = 0; m < 4; ++m) { const int r = ai * HALF + wr * 64 + m * 16 + fr; const float rstd = 1.f / sqrtf(S[r] * (1.f / 1024.f) + 1e-6f);
                        __builtin_nontemporal_store(acc[ai][bj][m][n] * rstd * g, (f32x4*)(out + (size_t)(u.pm * BM + r) * 1024 + c)); } }
    }
};

template <class Epi, class Sched, bool ALIGN_EPI = false, bool SP2 = false>
__device__ __forceinline__ void gemm_phase(PG8_LAS unsigned char* lds, const Gemm g, const Sched& S, const Epi& E) {
    int tid_o = threadIdx.x; asm volatile("" : "+v"(tid_o));
    const int tid = tid_o, wid = __builtin_amdgcn_readfirstlane(tid >> 6), lane = tid & 63, wr = wid >> 2, wc = wid & 3, fr = lane & 15, fq = lane >> 4;
    const int K = g.K, nt = K / BK;
    unsigned voffA[2], voffB[2];
#pragma unroll
    for (int i = 0; i < 2; ++i) { int R, C; stage_rc(tid * 16 + i * 8192, R, C); const int Rb = Epi::PERM ? ((R & ~31) + perm32(R & 31)) : R;
        voffA[i] = (unsigned)(R * g.lda + C) * 2u; voffB[i] = (unsigned)(Rb * g.ldb + C) * 2u; }
    const size_t kstep = (size_t)(BK * 2);
    const size_t hstepA = (size_t)HALF * g.lda * 2, hstepB = (size_t)HALF * g.ldb * 2;
    const unsigned ldsw = (unsigned)wid * 1024u;
    const int aoff = lds_byte(wr * 64 + fr, fq * 8), boff = lds_byte(wc * 32 + fr, fq * 8);
#define PG8_SA(b, h) (((b) * 2 + (h)) * HTB)
#define PG8_SB(b, h) ((4 + (b) * 2 + (h)) * HTB)
#define PG8_STAGE(bufoff, gbase, voff) do { _Pragma("unroll") for (int _i = 0; _i < 2; ++_i) \
        __builtin_amdgcn_global_load_lds((const unsigned*)((const char*)(gbase) + (voff)[_i]), (PG8_LAS unsigned*)(lds + (bufoff) + ldsw + _i * 8192), 16, 0, 0); } while (0)
#define PG8_LDA(dst, b, h) do { _Pragma("unroll") for (int m = 0; m < 4; ++m) _Pragma("unroll") for (int k = 0; k < 2; ++k) dst[m][k] = *(const PG8_LAS bf16x8*)(lds + PG8_SA(b, h) + aoff + m * 2048 + k * 1024); } while (0)
#define PG8_LDB(dst, b, h) do { _Pragma("unroll") for (int n = 0; n < 2; ++n) _Pragma("unroll") for (int k = 0; k < 2; ++k) dst[n][k] = *(const PG8_LAS bf16x8*)(lds + PG8_SB(b, h) + boff + n * 2048 + k * 1024); } while (0)
#define PG8_MMA(ai, bj, At, Bt) do { __builtin_amdgcn_s_setprio(1); _Pragma("unroll") for (int m = 0; m < 4; ++m) _Pragma("unroll") for (int n = 0; n < 2; ++n) _Pragma("unroll") for (int k = 0; k < 2; ++k) \
        acc[ai][bj][m][n] = __builtin_amdgcn_mfma_f32_16x16x32_bf16(Bt[n][k], At[m][k], acc[ai][bj][m][n], 0, 0, 0); __builtin_amdgcn_s_setprio(0); } while (0)
#define PG8_WAIT_V(n) asm volatile("s_waitcnt vmcnt(" #n ")" ::: "memory")
#define PG8_WAIT_L(n) asm volatile("s_waitcnt lgkmcnt(" #n ")" ::: "memory")
#define PG8_BAR __builtin_amdgcn_s_barrier()
#define PG8_SCHED __builtin_amdgcn_sched_barrier(0)
    Unit cur, nxt; int ui = 0;
    if (!S.next(0, cur)) return;
    f32x4 acc[2][2][4][2];
#pragma unroll
    for (int a = 0; a < 2; ++a)
#pragma unroll
        for (int b = 0; b < 2; ++b)
#pragma unroll
            for (int m = 0; m < 4; ++m)
#pragma unroll
                for (int n = 0; n < 2; ++n) acc[a][b][m][n] = (f32x4){0.f, 0.f, 0.f, 0.f};
    bf16x8 At[4][2], B0[2][2], B1[2][2];
    const char* cA = S.aptr(g, cur); const char* cB = S.bptr(g, cur);
    S.a_ready(cur);
    if constexpr (SP2) {
        PG8_STAGE(PG8_SB(0, 0), cB, voffB); PG8_STAGE(PG8_SB(0, 1), cB + hstepB, voffB); PG8_STAGE(PG8_SA(0, 0), cA, voffA); PG8_STAGE(PG8_SA(0, 1), cA + hstepA, voffA);
        if (wr == 1) PG8_BAR;
        PG8_WAIT_V(2); PG8_BAR;
        PG8_STAGE(PG8_SB(1, 0), cB + kstep, voffB); PG8_STAGE(PG8_SA(1, 0), cA + kstep, voffA); PG8_STAGE(PG8_SB(1, 1), cB + hstepB + kstep, voffB);
        PG8_WAIT_V(6); PG8_BAR;
    } else {
        PG8_STAGE(PG8_SB(0, 0), cB, voffB); PG8_STAGE(PG8_SA(0, 0), cA, voffA); PG8_STAGE(PG8_SB(0, 1), cB + hstepB, voffB); PG8_STAGE(PG8_SA(0, 1), cA + hstepA, voffA);
        if (wr == 1) PG8_BAR;
        PG8_WAIT_V(4); PG8_BAR;
        PG8_STAGE(PG8_SB(1, 0), cB + kstep, voffB); PG8_STAGE(PG8_SA(1, 0), cA + kstep, voffA); PG8_STAGE(PG8_SB(1, 1), cB + hstepB + kstep, voffB);
        PG8_WAIT_V(6); PG8_BAR;
    }
    for (;;) {
        const bool has_next = S.next(ui + 1, nxt);
        const char* nA = has_next ? S.aptr(g, nxt) : cA; const char* nB = has_next ? S.bptr(g, nxt) : cB;
        for (int t = 0; t < nt; t += 2) {
            const bool last = (t == nt - 2);
            const long d1 = (g.ksplit > 0 && t + 1 >= g.ksplit) ? g.adelta : 0, d2 = (g.ksplit > 0 && !last && t + 2 >= g.ksplit) ? g.adelta : 0, d3 = (g.ksplit > 0 && !last && t + 3 >= g.ksplit) ? g.adelta : 0;
            const char* a1 = cA + (size_t)(t + 1) * kstep + d1;
            const char* a2 = (last ? nA : cA + (size_t)(t + 2) * kstep) + d2; const char* b2 = last ? nB : cB + (size_t)(t + 2) * kstep;
            const char* a3 = (last ? nA : cA + (size_t)(t + 2) * kstep) + kstep + d3; const char* b3 = b2 + kstep;
            if (last && has_next) S.a_ready(nxt);
            if constexpr (SP2) {
            PG8_LDB(B0, 0, 0); PG8_LDB(B1, 0, 1); PG8_SCHED; PG8_LDA(At, 0, 0); PG8_STAGE(PG8_SA(1, 1), a1 + hstepA, voffA);
            PG8_WAIT_V(8); PG8_WAIT_L(0); PG8_BAR; PG8_MMA(0, 0, At, B0); PG8_MMA(0, 1, At, B1); PG8_BAR; PG8_SCHED;
            PG8_LDA(At, 0, 1); PG8_STAGE(PG8_SB(0, 0), b2, voffB); PG8_STAGE(PG8_SB(0, 1), b2 + hstepB, voffB); PG8_STAGE(PG8_SA(0, 0), a2, voffA);
            PG8_WAIT_V(8); PG8_WAIT_L(0); PG8_BAR; PG8_MMA(1, 0, At, B0); PG8_MMA(1, 1, At, B1); PG8_BAR; PG8_SCHED;
            PG8_LDB(B0, 1, 0); PG8_LDB(B1, 1, 1); PG8_SCHED; PG8_LDA(At, 1, 0); PG8_STAGE(PG8_SA(0, 1), a2 + hstepA, voffA);
            PG8_WAIT_V(8); PG8_WAIT_L(0); PG8_BAR; PG8_MMA(0, 0, At, B0); PG8_MMA(0, 1, At, B1); PG8_BAR; PG8_SCHED;
            PG8_LDA(At, 1, 1); PG8_STAGE(PG8_SB(1, 0), b3, voffB); PG8_STAGE(PG8_SB(1, 1), b3 + hstepB, voffB); PG8_STAGE(PG8_SA(1, 0), a3, voffA);
            PG8_WAIT_V(8); PG8_WAIT_L(0); PG8_BAR; PG8_MMA(1, 0, At, B0); PG8_MMA(1, 1, At, B1); PG8_BAR; PG8_SCHED;
            } else {
            PG8_LDB(B0, 0, 0); PG8_SCHED; PG8_LDA(At, 0, 0); PG8_STAGE(PG8_SA(1, 1), a1 + hstepA, voffA);
            PG8_WAIT_L(8); PG8_BAR; PG8_WAIT_L(0); PG8_MMA(0, 0, At, B0); PG8_BAR; PG8_SCHED;
            PG8_LDB(B1, 0, 1); PG8_STAGE(PG8_SB(0, 0), b2, voffB);
            PG8_BAR; PG8_WAIT_L(0); PG8_MMA(0, 1, At, B1); PG8_BAR;
            PG8_LDA(At, 0, 1); PG8_STAGE(PG8_SA(0, 0), a2, voffA);
            PG8_BAR; PG8_WAIT_L(0); PG8_MMA(1, 0, At, B0); PG8_BAR; PG8_SCHED;
            PG8_STAGE(PG8_SB(0, 1), b2 + hstepB, voffB);
            PG8_WAIT_V(6); PG8_BAR; PG8_MMA(1, 1, At, B1); PG8_BAR;
            PG8_LDB(B0, 1, 0); PG8_SCHED; PG8_LDA(At, 1, 0); PG8_STAGE(PG8_SA(0, 1), a2 + hstepA, voffA);
            PG8_WAIT_L(8); PG8_BAR; PG8_WAIT_L(0); PG8_MMA(0, 0, At, B0); PG8_BAR; PG8_SCHED;
            PG8_LDB(B1, 1, 1); PG8_STAGE(PG8_SB(1, 0), b3, voffB);
            PG8_BAR; PG8_WAIT_L(0); PG8_MMA(0, 1, At, B1); PG8_BAR;
            PG8_LDA(At, 1, 1); PG8_STAGE(PG8_SA(1, 0), a3, voffA);
            PG8_BAR; PG8_WAIT_L(0); PG8_MMA(1, 0, At, B0); PG8_BAR; PG8_SCHED;
            PG8_STAGE(PG8_SB(1, 1), b3 + hstepB, voffB);
            PG8_WAIT_V(6); PG8_BAR; PG8_MMA(1, 1, At, B1); PG8_BAR;
            }
        }
        if constexpr (ALIGN_EPI) { if (wr == 0) PG8_BAR; }
        if constexpr (!Epi::AFTER_DRAIN) { E(acc, cur, wr, wc, fr, fq); S.done(cur); }
        if (!has_next) break;
#pragma unroll
        for (int a = 0; a < 2; ++a)
#pragma unroll
            for (int b = 0; b < 2; ++b)
#pragma unroll
                for (int m = 0; m < 4; ++m)
#pragma unroll
                    for (int n = 0; n < 2; ++n) acc[a][b][m][n] = (f32x4){0.f, 0.f, 0.f, 0.f};
        cur = nxt; cA = nA; cB = nB; ++ui;
        if constexpr (ALIGN_EPI) { if (wr == 1) PG8_BAR; }
    }
    PG8_WAIT_V(0);
    if constexpr (!ALIGN_EPI) { if (wr == 0) PG8_BAR; }
    PG8_BAR;
    if constexpr (Epi::AFTER_DRAIN) { E.fused(acc, cur, wr, wc, fr, fq, lds, wid, lane); S.done(cur); }
#undef PG8_SA
#undef PG8_SB
#undef PG8_STAGE
#undef PG8_LDA
#undef PG8_LDB
#undef PG8_MMA
#undef PG8_WAIT_V
#undef PG8_WAIT_L
#undef PG8_BAR
#undef PG8_SCHED
}
}

constexpr int NWAVES = 8;
constexpr int D = 1024, BATCH = 8, SEQ = 2048, CTXL = 256;
constexpr int MLAT = BATCH * SEQ;
constexpr int MCTX = BATCH * CTXL;
constexpr int MTOT = MLAT + MCTX;
constexpr int FW = 512, CW = 512, NH = 8, HD = 64;
constexpr int PROJ = 2432, PROJP = 2560;
constexpr int DFF = 2816, F2 = 5632;
constexpr int MODW = 6 * D;

constexpr size_t MiB = 1u << 20;
constexpr size_t WS_CTL = 0, CTL_ZERO_BYTES = 512 * 1024;
constexpr size_t WS_PTRS = 128 * 1024;
constexpr size_t WS_ALT = 480 * 1024;
constexpr size_t WS_MOD = 256 * 1024;
constexpr size_t WS_WOUT = 1 * MiB;
constexpr size_t WS_UR = 3 * MiB;
constexpr size_t WS_H = 75 * MiB;
constexpr size_t WS_WIN = 111 * MiB;
constexpr size_t WS_ADFT = 116 * MiB;
constexpr size_t WS_UF = 124 * MiB;
constexpr size_t WS_PQT = 140 * MiB;
constexpr size_t OUT_YF = 0;
constexpr size_t REC_BYTES = 10496, REC_BATCH = (size_t)144 * 8 * 2 * REC_BYTES;
constexpr size_t WS_REC06 = 75 * MiB, OUT_REC7 = 32 * MiB;
constexpr size_t WS_VD = 237 * MiB;
constexpr size_t OUT_SGD = 56 * MiB, OUT_COEF = 60 * MiB, OUT_COEF2 = 61 * MiB;
static_assert(WS_REC06 + 7 * REC_BATCH <= WS_VD && OUT_REC7 + REC_BATCH <= OUT_SGD && WS_VD + 18 * MiB <= 256 * MiB, "record regions");
constexpr size_t WS_W2T = 512 * 1024, WS_A2T = WS_W2T + 131072, WS_G2T = WS_A2T + 131072;
constexpr size_t WS_Y0 = 3 * MiB, WS_Y1 = 19 * MiB;
constexpr size_t WS_FN = 52 * MiB;
constexpr size_t WS_AR = 75 * MiB;
constexpr size_t WS_WUP = 35 * MiB;
constexpr size_t WS_WDN = 46 * MiB;
constexpr size_t WS_H2 = 3 * MiB;
constexpr size_t WS_XBUF = 156 * MiB;
constexpr size_t WS_U2 = 160 * MiB;
constexpr size_t WS_ACT = 52 * MiB;
constexpr size_t WS_END = 256 * MiB;
constexpr int CW_BAR = 4096;
constexpr int CW_MODCNT = 3840;
constexpr int CW_F2DONE = 8192, CW_P7DONE = 8256;
constexpr int CW_SEAM = 16384, SEAM_BANK = 4096;

constexpr int RING_BYTES = 131072;
constexpr int LDSCTL_OFF = RING_BYTES, MISC_OFF = LDSCTL_OFF + 320;
constexpr int LDS_BYTES = 147456;

#define LAS __attribute__((address_space(3)))
typedef unsigned short bf16;
typedef unsigned v4u __attribute__((ext_vector_type(4)));
typedef unsigned v2u __attribute__((ext_vector_type(2)));
typedef float f32x4 __attribute__((ext_vector_type(4)));
#define LDS_WAIT() asm volatile("s_waitcnt lgkmcnt(0)" ::: "memory")
__device__ __forceinline__ unsigned f2bf(float f) { unsigned u = __builtin_bit_cast(unsigned, f); return (u + 0x7fffu + ((u >> 16) & 1u)) >> 16; }
__device__ __forceinline__ unsigned pk2(float lo, float hi) { return f2bf(lo) | (f2bf(hi) << 16); }
__device__ __forceinline__ float bf2f(unsigned short b) { return __builtin_bit_cast(float, ((unsigned)b) << 16); }
__device__ __forceinline__ float bflo(unsigned w) { return __builtin_bit_cast(float, w << 16); }
__device__ __forceinline__ float bfhi(unsigned w) { return __builtin_bit_cast(float, w & 0xffff0000u); }
__device__ __forceinline__ float sigmoidf_(float x) { return 1.f / (1.f + __expf(-x)); }
__device__ __forceinline__ float wave_sum(float v) {
#pragma unroll
    for (int o = 1; o < 64; o <<= 1) v += __shfl_xor(v, o);
    return v;
}

#define XB_TMO      128
#define XB_XCNT(j)  (256  + 64 * (j))
#define XB_XSUB(j)  (1280 + 64 * (j))
#define XB_XGEN(j)  (2304 + 64 * (j))
#define XB_TOP      3328
#define XB_TOPGEN   3392
#define XCD_BAR_WORDS 3456
#define XB_SPIN_CAP (1u << 20)
__device__ __forceinline__ unsigned xb_ld(unsigned* p)              { return __hip_atomic_load(p, __ATOMIC_RELAXED, __HIP_MEMORY_SCOPE_AGENT); }
__device__ __forceinline__ unsigned xb_add(unsigned* p, unsigned v) { return __hip_atomic_fetch_add(p, v, __ATOMIC_RELAXED, __HIP_MEMORY_SCOPE_AGENT); }
__device__ __forceinline__ unsigned xb_xcc_id() { return (unsigned)__builtin_amdgcn_s_getreg((3 << 11) | 20) & 0xFu; }
#define XB_SPIN(cond, bar) do { unsigned _sp = 0; while (cond) { if (_sp < 32u) __builtin_amdgcn_s_sleep(1); else if (_sp < 128u) __builtin_amdgcn_s_sleep(4); else __builtin_amdgcn_s_sleep(16);     \
    if ((++_sp & 255u) == 0u) { if (xb_ld(&(bar)[XB_TMO])) break; if (_sp > XB_SPIN_CAP) { atomicAdd(&(bar)[XB_TMO], 1u); break; } } } } while (0)
struct XcdBarrier { unsigned* bar; unsigned x; volatile LAS unsigned* st; };
__device__ __forceinline__ XcdBarrier xcd_barrier_post(unsigned* bar, volatile LAS unsigned* st) {
    XcdBarrier b; b.bar = bar; b.x = xb_xcc_id(); b.st = st;
    if (threadIdx.x == 0) (void)xb_add(&bar[XB_XCNT(b.x)], 1u);
    return b;
}
__device__ __forceinline__ void xcd_barrier_complete(unsigned* bar, unsigned x, unsigned& nloc, unsigned& nx) {
    const unsigned G = gridDim.x * gridDim.y * gridDim.z;
    unsigned sum, cnt, mine, sp = 0u;
    for (;;) {
        sum = 0u; cnt = 0u; mine = 0u;
#pragma unroll
        for (unsigned j = 0; j < 16; ++j) { const unsigned c = xb_ld(&bar[XB_XCNT(j)]); sum += c; cnt += (c > 0u) ? 1u : 0u; mine = (j == x) ? c : mine; }
        if (sum == G) break;
        __builtin_amdgcn_s_sleep(1);
        if ((++sp & 255u) == 0u) { if (xb_ld(&bar[XB_TMO])) break; if (sp > XB_SPIN_CAP) { atomicAdd(&bar[XB_TMO], 1u); break; } }
    }
    nloc = mine > 0u ? mine : 1u; nx = cnt > 0u ? cnt : 1u;
}
__device__ __forceinline__ void xcd_barrier(const XcdBarrier& b) {
    asm volatile("s_waitcnt vmcnt(0)" ::: "memory");
    __syncthreads();
    if (threadIdx.x == 0) {
        unsigned* bar = b.bar;
        __builtin_amdgcn_s_waitcnt(0);
        unsigned nloc = b.st[0], nx = b.st[1];
        if (nloc == 0u) { xcd_barrier_complete(bar, b.x, nloc, nx); b.st[0] = nloc; b.st[1] = nx; }
        const unsigned old = xb_add(&bar[XB_XSUB(b.x)], 1u);
        const unsigned gen = old / nloc;
        if (old + 1u == (gen + 1u) * nloc) {
            __builtin_amdgcn_fence(__ATOMIC_RELEASE, "agent");
            asm volatile("s_waitcnt vmcnt(0)" ::: "memory");
            const unsigned og = xb_add(&bar[XB_TOP], 1u);
            const unsigned tg = og / nx;
            if (og + 1u == (tg + 1u) * nx) xb_add(&bar[XB_TOPGEN], 1u);
            else XB_SPIN(xb_ld(&bar[XB_TOPGEN]) == tg, bar);
            __builtin_amdgcn_fence(__ATOMIC_ACQUIRE, "agent");
            xb_add(&bar[XB_XGEN(b.x)], 1u);
            asm volatile("s_waitcnt vmcnt(0)" ::: "memory");
        } else {
            XB_SPIN(xb_ld(&bar[XB_XGEN(b.x)]) == gen, bar);
            __builtin_amdgcn_fence(__ATOMIC_ACQUIRE, "agent");
            asm volatile("s_waitcnt vmcnt(0)" ::: "memory");
        }
    }
    __syncthreads();
}

__device__ __forceinline__ void transpose_item(const float* W, int K, int N, bf16* WT, int row_off, LAS float* scr, int item, int lane) {
    const int nblk = N / 32, kb = item / nblk, nb = item % nblk, k0 = 64 * kb, n0 = 32 * nb;
    f32x4 v[8];
#pragma unroll
    for (int i = 0; i < 8; ++i) v[i] = __builtin_nontemporal_load((const f32x4*)(W + (size_t)(k0 + (lane >> 3) + 8 * i) * N + n0 + 4 * (lane & 7)));
#pragma unroll
    for (int i = 0; i < 8; ++i) { LAS float* d = scr + ((lane >> 3) + 8 * i) * 33 + 4 * (lane & 7); d[0] = v[i].x; d[1] = v[i].y; d[2] = v[i].z; d[3] = v[i].w; }
    LDS_WAIT(); asm volatile("" ::: "memory");
    const int c = lane & 7;
#pragma unroll
    for (int j = 0; j < 4; ++j) { const int n = (lane >> 3) + 8 * j; const LAS float* s = scr + (8 * c) * 33 + n;
        v4u o; o.x = pk2(s[0 * 33], s[1 * 33]); o.y = pk2(s[2 * 33], s[3 * 33]); o.z = pk2(s[4 * 33], s[5 * 33]); o.w = pk2(s[6 * 33], s[7 * 33]);
        *(v4u*)(WT + (size_t)(row_off + n0 + n) * K + k0 + 8 * c) = o; }
    LDS_WAIT(); asm volatile("" ::: "memory");
}

__device__ __forceinline__ void norm_mod_row(const float* xrow, const float* g, const float* modrow, const float* adab, int shoff, int scoff, bf16* orow, int lane) {
    f32x4 v[4]; float s = 0.f;
#pragma unroll
    for (int j = 0; j < 4; ++j) { v[j] = __builtin_nontemporal_load((const f32x4*)(xrow + 4 * lane + 256 * j)); s += (v[j].x * v[j].x + v[j].y * v[j].y) + (v[j].z * v[j].z + v[j].w * v[j].w); }
    const float rstd = 1.f / sqrtf(wave_sum(s) * (1.f / D) + 1e-6f);
#pragma unroll
    for (int j = 0; j < 4; ++j) { const int c = 4 * lane + 256 * j;
        const f32x4 gg = *(const f32x4*)(g + c);
        const f32x4 sc = *(const f32x4*)(modrow + scoff + c) + *(const f32x4*)(adab + scoff + c);
        const f32x4 sh = *(const f32x4*)(modrow + shoff + c) + *(const f32x4*)(adab + shoff + c);
        const f32x4 y = (v[j] * rstd * gg) * (sc + 1.f) + sh;
        v2u o; o.x = pk2(y.x, y.y); o.y = pk2(y.z, y.w);
        *(v2u*)(orow + c) = o; }
}


__device__ __forceinline__ void norm_mod_load(const float* xrow, f32x4 (&v)[4], int lane) {
#pragma unroll
    for (int j = 0; j < 4; ++j) v[j] = __builtin_nontemporal_load((const f32x4*)(xrow + 4 * lane + 256 * j));
}
__device__ __forceinline__ void norm_mod_finish(const f32x4 (&v)[4], const float* g, const float* modrow, const float* adab, int shoff, int scoff, bf16* orow, int lane) {
    float s = 0.f;
#pragma unroll
    for (int j = 0; j < 4; ++j) s += (v[j].x * v[j].x + v[j].y * v[j].y) + (v[j].z * v[j].z + v[j].w * v[j].w);
    const float rstd = 1.f / sqrtf(wave_sum(s) * (1.f / D) + 1e-6f);
#pragma unroll
    for (int j = 0; j < 4; ++j) { const int c = 4 * lane + 256 * j;
        const f32x4 gg = *(const f32x4*)(g + c);
        const f32x4 sc = *(const f32x4*)(modrow + scoff + c) + *(const f32x4*)(adab + scoff + c);
        const f32x4 sh = *(const f32x4*)(modrow + shoff + c) + *(const f32x4*)(adab + shoff + c);
        const f32x4 y = (v[j] * rstd * gg) * (sc + 1.f) + sh;
        v2u o; o.x = pk2(y.x, y.y); o.y = pk2(y.z, y.w);
        *(v2u*)(orow + c) = o; }
}
__device__ __forceinline__ float sigm_fast(float x) { return __builtin_amdgcn_rcpf(1.f + __builtin_amdgcn_exp2f(-1.442695041f * x)); }
__device__ __forceinline__ float tanh_fast(float x) { return 1.f - 2.f * __builtin_amdgcn_rcpf(1.f + __builtin_amdgcn_exp2f(2.885390082f * x)); }
template <int K> __device__ __forceinline__ float dpp_shr(float x) { return __builtin_bit_cast(float, __builtin_amdgcn_update_dpp(0, __builtin_bit_cast(int, x), 0x110 | K, 0xf, 0xf, true)); }
template <int C> __device__ __forceinline__ float dpp_ctl(float x) { return __builtin_bit_cast(float, __builtin_amdgcn_update_dpp(0, __builtin_bit_cast(int, x), C, 0xf, 0xf, true)); }
template <int K> __device__ __forceinline__ float dpp_shl(float x) { return __builtin_bit_cast(float, __builtin_amdgcn_update_dpp(0, __builtin_bit_cast(int, x), 0x100 | K, 0xf, 0xf, true)); }
__device__ __forceinline__ pg8::bf16x8 pack8(const float (&a)[4], const float (&b)[4]) {
    v4u w; w.x = pg8::cvt_pk_bf16(a[0], a[1]); w.y = pg8::cvt_pk_bf16(a[2], a[3]); w.z = pg8::cvt_pk_bf16(b[0], b[1]); w.w = pg8::cvt_pk_bf16(b[2], b[3]); return __builtin_bit_cast(pg8::bf16x8, w); }
__device__ __forceinline__ pg8::bf16x8 dop4(const f32x4 v) { v4u w; w.x = pg8::cvt_pk_bf16(v[0], v[1]); w.y = pg8::cvt_pk_bf16(v[2], v[3]); w.z = 0u; w.w = 0u; return __builtin_bit_cast(pg8::bf16x8, w); }
#define GRAM(Xf, Yf) __builtin_amdgcn_mfma_f32_16x16x32_bf16(Xf[1], Yf[1], __builtin_amdgcn_mfma_f32_16x16x32_bf16(Xf[0], Yf[0], z4, 0, 0, 0), 0, 0, 0)
__device__ __forceinline__ unsigned char* recbase(unsigned char* ws, unsigned char* outb, int b) {
    return b < 7 ? ws + WS_REC06 + (size_t)b * REC_BATCH : outb + OUT_REC7;
}

struct Args { const float* in[27]; float* out; unsigned char* ws; };

__global__ void __launch_bounds__(NWAVES * 64, 2) fwd_kernel(Args args) {
    extern __shared__ __attribute__((aligned(16))) unsigned char lds_raw[];
    LAS unsigned char* lds = (LAS unsigned char*)lds_raw;
    volatile LAS unsigned* MISC = (volatile LAS unsigned*)(lds + MISC_OFF);
    const int tid0 = threadIdx.x, wave = __builtin_amdgcn_readfirstlane(tid0 >> 6);
    const int G = gridDim.x, bx = blockIdx.x;
    const int gw = bx * NWAVES + wave, NGW = G * NWAVES;
    const int NGT = G * NWAVES * 64;
#define PHASE_VARS int tid = threadIdx.x; asm volatile("" : "+v"(tid)); const int lane = tid & 63; const int gt = bx * (NWAVES * 64) + tid; (void)lane; (void)gt;
    unsigned* ctl = (unsigned*)(args.ws + WS_CTL);
    unsigned char* const P_ws = args.ws; float* const P_outp = args.out;
#define P_outb ((unsigned char*)P_outp)
#define P_modb ((float*)(P_ws + WS_MOD))
#define TABP(k) ((const float*)(const __attribute__((address_space(1))) float*)(((const unsigned long long*)(P_ws + WS_PTRS))[k]))

    for (int u = tid0; u < (LDS_BYTES - LDSCTL_OFF) / 4; u += NWAVES * 64) ((LAS unsigned*)(lds + LDSCTL_OFF))[u] = 0u;
    __syncthreads();
    XcdBarrier bar = xcd_barrier_post(ctl + CW_BAR, MISC + 8);
#define GRID_BAR() xcd_barrier(bar)

#define MOD_GEMV(IT0, IT1) \
        for (int it = (IT0) + gw; it < (IT1); it += NGW) {     \
            const int cb = it >> 5, kc = it & 31, k0 = kc * 32, n0 = cb * 256 + lane * 4; \
            float sb[9]; \
            _Pragma("unroll") for (int b = 0; b < 9; ++b) { const float cv = (b < 8) ? args.in[1][b * D + k0 + (lane & 31)] : args.in[3][k0 + (lane & 31)]; sb[b] = cv / (1.f + __expf(-cv)); } \
            f32x4 acc[9]; \
            _Pragma("unroll") for (int b = 0; b < 9; ++b) acc[b] = (f32x4){0.f, 0.f, 0.f, 0.f}; \
            _Pragma("unroll") for (int kk = 0; kk < 32; ++kk) { \
                const f32x4 wv = *(const f32x4*)(args.in[4] + (size_t)(k0 + kk) * MODW + n0); \
                _Pragma("unroll") for (int b = 0; b < 9; ++b) { const float s = __builtin_bit_cast(float, __builtin_amdgcn_readlane(__builtin_bit_cast(int, sb[b]), kk)); acc[b] += wv * s; } \
            } \
            _Pragma("unroll") for (int b = 0; b < 9; ++b) { float* p = P_modb + b * MODW + n0; atomicAdd(p, acc[b].x); atomicAdd(p + 1, acc[b].y); atomicAdd(p + 2, acc[b].z); atomicAdd(p + 3, acc[b].w); } \
        }
    {
        PHASE_VARS
        unsigned* modcnt = ctl + CW_MODCNT;
        const bool fastg = (G >= 64 * 2);
        if (fastg && bx < 64) {
            const int cb = bx >> 3, k0 = (bx & 7) * 128 + wave * 16, n0 = cb * 256 + lane * 4;
            float sb[9];
#pragma unroll
            for (int b = 0; b < 9; ++b) { const float cv = (b < 8) ? args.in[1][b * D + k0 + (lane & 15)] : args.in[3][k0 + (lane & 15)]; sb[b] = cv / (1.f + __expf(-cv)); }
            f32x4 acc[9];
#pragma unroll
            for (int b = 0; b < 9; ++b) acc[b] = (f32x4){0.f, 0.f, 0.f, 0.f};
#pragma unroll
            for (int kk = 0; kk < 16; ++kk) {
                const f32x4 wv = *(const f32x4*)(args.in[4] + (size_t)(k0 + kk) * MODW + n0);
#pragma unroll
                for (int b = 0; b < 9; ++b) { const float s_ = __builtin_bit_cast(float, __builtin_amdgcn_readlane(__builtin_bit_cast(int, sb[b]), kk)); acc[b] += wv * s_; }
            }
            LAS float* red = (LAS float*)lds;
#pragma unroll
            for (int b = 0; b < 9; ++b) *(LAS f32x4*)(red + (wave * 9 + b) * 256 + lane * 4) = acc[b];
            __syncthreads();
            for (int q = tid; q < 9 * 64; q += NWAVES * 64) { const int b = q >> 6, c4 = (q & 63) * 4;
                f32x4 t = *(const LAS f32x4*)(red + b * 256 + c4);
#pragma unroll
                for (int w = 1; w < 8; ++w) t += *(const LAS f32x4*)(red + (w * 9 + b) * 256 + c4);
                float* p_ = P_modb + b * MODW + cb * 256 + c4; atomicAdd(p_, t.x); atomicAdd(p_ + 1, t.y); atomicAdd(p_ + 2, t.z); atomicAdd(p_ + 3, t.w); }
            asm volatile("s_waitcnt vmcnt(0)" ::: "memory");
            __syncthreads();
            if (tid == 0) { __builtin_amdgcn_fence(__ATOMIC_RELEASE, "agent"); asm volatile("s_waitcnt vmcnt(0)" ::: "memory"); __hip_atomic_fetch_add(modcnt, 4u, __ATOMIC_RELAXED, __HIP_MEMORY_SCOPE_AGENT); }
        } else if (!fastg) {
            MOD_GEMV(0, 8 * 32)
            asm volatile("s_waitcnt vmcnt(0)" ::: "memory");
            __syncthreads();
            if (tid == 0 && bx * NWAVES < 256) { __builtin_amdgcn_fence(__ATOMIC_RELEASE, "agent"); asm volatile("s_waitcnt vmcnt(0)" ::: "memory"); const int mine = (256 - bx * NWAVES) < NWAVES ? (256 - bx * NWAVES) : NWAVES;
                __hip_atomic_fetch_add(modcnt, (unsigned)mine, __ATOMIC_RELAXED, __HIP_MEMORY_SCOPE_AGENT); }
        }
        if (!fastg || bx >= 64) {
            const int ob = fastg ? bx - 64 : bx, on = fastg ? G - 64 : G;
            const int ogw = ob * NWAVES + wave, ONGW = on * NWAVES, ogt = ob * (NWAVES * 64) + tid, ONGT = on * (NWAVES * 64);
            LAS float* scr = (LAS float*)(lds + wave * 16384);
            bf16* WinT = (bf16*)(P_ws + WS_WIN);
            constexpr int I_IN = (D / 64) * (PROJ / 32);
            for (int it = ogw; it < I_IN; it += ONGW) transpose_item(args.in[8], D, PROJ, WinT, 0, scr, it, lane);
            for (int i = ogt; i < (PROJP - PROJ) * D / 8; i += ONGT) *(v4u*)(WinT + (size_t)PROJ * D + (size_t)i * 8) = (v4u){0u, 0u, 0u, 0u};
            {
                bf16* W2T = (bf16*)(P_ws + WS_W2T); bf16* A2T = (bf16*)(P_ws + WS_A2T); bf16* G2T = (bf16*)(P_ws + WS_G2T);
                for (int i = ogt; i < 2 * CW * 64; i += ONGT) { const int d = i >> 15, c = (i >> 6) & 511, rr = i & 63;
                    W2T[i] = (bf16)f2bf(args.in[11][(size_t)(d * 64 + rr) * CW + c]); A2T[i] = (bf16)f2bf(args.in[13][(size_t)(d * 64 + rr) * CW + c]); }
                for (int i = ogt; i < CW * 128; i += ONGT) { const int c = i >> 7, q = i & 127; G2T[i] = (bf16)f2bf(args.in[14][(size_t)q * CW + c]); }
            }
            {
                bf16* Adft = (bf16*)(P_ws + WS_ADFT);
                const float sc = 0.00276213586400995f;
                for (int i = ogt; i < 2048 * 256; i += ONGT) {
                    const int r = i >> 8, ch = i & 255, t0 = ch * 8, k = r & 1023; const bool isS = r >= 1024;
                    float v[8];
#pragma unroll
                    for (int j = 0; j < 8; ++j) { const float rev = (float)((k * (t0 + j)) & 2047) * (1.f / 2048.f); v[j] = (isS ? __builtin_amdgcn_sinf(rev) : __builtin_amdgcn_cosf(rev)) * sc; }
                    v4u o; o.x = pk2(v[0], v[1]); o.y = pk2(v[2], v[3]); o.z = pk2(v[4], v[5]); o.w = pk2(v[6], v[7]);
                    *(v4u*)(Adft + (size_t)r * 2048 + (size_t)ch * 8) = o;
                }
            }
        }
        if (bx == 0 && tid < 27) ((const float**)(P_ws + WS_PTRS))[tid] = args.in[tid];
        {
            const float* const P_x = args.in[0];
            const float* const P_ctx = args.in[2];
            const float* const P_ada_b = args.in[5];
            const float* const P_norm1_g = args.in[6];
            bf16* Hb = (bf16*)(P_ws + WS_H);
#define P1_LOAD3(xv_, row0_) do { _Pragma("unroll") for (int j = 0; j < 3; ++j) { const int rw = (row0_) + j * NGW, row = rw < MTOT ? rw : (row0_); \
                norm_mod_load(row < MLAT ? P_x + (size_t)row * D : P_ctx + (size_t)(row - MLAT) * D, xv_[j], lane); } } while (0)
#define P1_FIN3(xv_, row0_) do { _Pragma("unroll") for (int j = 0; j < 3; ++j) { const int row = (row0_) + j * NGW; if (row < MTOT) { const int mb = row < MLAT ? (row >> 11) : 8; \
                norm_mod_finish(xv_[j], P_norm1_g, P_modb + (size_t)mb * MODW, P_ada_b, 0, D, Hb + (size_t)row * D, lane); } } } while (0)
            f32x4 xa[3][4], xb[3][4], xc[3][4];
            const int rA = gw, rB = gw + 3 * NGW, rC = gw + 6 * NGW;
            if (rA < MTOT) P1_LOAD3(xa, rA);
            if (rB < MTOT) P1_LOAD3(xb, rB);
            if (rC < MTOT) P1_LOAD3(xc, rC);
            if (tid == 0) { unsigned spins = 0;
                while (__hip_atomic_load(modcnt, __ATOMIC_RELAXED, __HIP_MEMORY_SCOPE_AGENT) < 256u) { __builtin_amdgcn_s_sleep(2); if (++spins > (1u << 22)) break; }
                __builtin_amdgcn_fence(__ATOMIC_ACQUIRE, "agent"); asm volatile("s_waitcnt vmcnt(0)" ::: "memory"); }
            __syncthreads();
            if (rA < MTOT) P1_FIN3(xa, rA);
            if (rB < MTOT) P1_FIN3(xb, rB);
            if (rC < MTOT) P1_FIN3(xc, rC);
            for (int row0 = gw + 9 * NGW; row0 < MTOT; row0 += 3 * NGW) { P1_LOAD3(xa, row0); P1_FIN3(xa, row0); }
#undef P1_LOAD3
#undef P1_FIN3
        }
    }
    GRID_BAR();

    REPS(10)
    {
        PHASE_VARS
        const float* const P_w_in = TABP(8);
        pg8::Gemm g{(const bf16*)(P_ws + WS_H), (const bf16*)(P_ws + WS_WIN), MTOT, PROJP, D, D, D, 0, 0}; pg8::StaticOrder S; S.init(MTOT, PROJP, G, bx);
        pg8::EpiU E{(bf16*)(P_ws + WS_UF), (bf16*)(P_ws + WS_UR)};
        pg8::gemm_phase<pg8::EpiU, pg8::StaticOrder, true, true>(lds, g, S, E);
    }
    GRID_BAR();

    REPS(1)
    {
        PHASE_VARS
        const int g = lane >> 4, n = lane & 15;
        const bf16* U = (const bf16*)(P_ws + WS_UF); bf16* PQt = (bf16*)(P_ws + WS_PQT);
        LAS float* twt = (LAS float*)(lds + 132096);
        if (tid < 64) { float sn, cs; sincospif((float)tid * (1.f / 32.f), &sn, &cs); twt[2 * tid] = cs; twt[2 * tid + 1] = sn; }
        __syncthreads();
        pg8::bf16x8 tw[8][2];
#pragma unroll
        for (int lt = 0; lt < 8; ++lt)
#pragma unroll
            for (int ks = 0; ks < 2; ++ks) { float v[8];
#pragma unroll
                for (int i = 0; i < 8; ++i) { const int l = 16 * (lt & 3) + n, c = 32 * ks + 8 * g + i; v[i] = twt[2 * ((l * c) & 63) + (lt >> 2)]; }
                v4u w; w.x = pg8::cvt_pk_bf16(v[0], v[1]); w.y = pg8::cvt_pk_bf16(v[2], v[3]); w.z = pg8::cvt_pk_bf16(v[4], v[5]); w.w = pg8::cvt_pk_bf16(v[6], v[7]); tw[lt][ks] = __builtin_bit_cast(pg8::bf16x8, w); }
        LAS unsigned short* stg = (LAS unsigned short*)(lds + wave * 16384);
        for (int it = gw; it < BATCH * 8 * 32; it += NGW) {
            const int tb = it & 31, gq = (it >> 5) & 7, b = it >> 8;
#pragma unroll
            for (int tt = 0; tt < 4; ++tt) {
                const bf16* ur = U + (size_t)(b * SEQ + tb * 64 + tt * 16 + n) * FW + gq * 64 + 8 * g;
                const pg8::bf16x8 b0 = *(const pg8::bf16x8*)ur, b1 = *(const pg8::bf16x8*)(ur + 32);
#pragma unroll
                for (int lt = 0; lt < 8; ++lt) {
                    f32x4 acc = __builtin_amdgcn_mfma_f32_16x16x32_bf16(tw[lt][0], b0, (f32x4){0.f, 0.f, 0.f, 0.f}, 0, 0, 0);
                    acc = __builtin_amdgcn_mfma_f32_16x16x32_bf16(tw[lt][1], b1, acc, 0, 0, 0);
#pragma unroll
                    for (int e = 0; e < 4; ++e) stg[(16 * lt + 4 * g + e) * 64 + tt * 16 + n] = (unsigned short)f2bf(acc[e]);
                }
                asm volatile("" ::: "memory");
            }
            LDS_WAIT(); asm volatile("" ::: "memory");
            {
                float alt = 0.f;
#pragma unroll
                for (int q = 0; q < 8; ++q) { const v4u w = *(const LAS v4u*)(stg + lane * 64 + q * 8);
                    alt += (bflo(w.x) - bfhi(w.x)) + (bflo(w.y) - bfhi(w.y)) + (bflo(w.z) - bfhi(w.z)) + (bflo(w.w) - bfhi(w.w)); }
                atomicAdd((float*)(P_ws + WS_ALT) + b * 512 + gq * 64 + lane, alt);
            }
            bf16* pbase = PQt + (size_t)(b * 512 + gq * 64) * 4096 + tb * 64;
#pragma unroll
            for (int q = 0; q < 16; ++q) { const int ch = q * 64 + lane, rw = ch >> 3, cc = ch & 7;
                const v4u w = *(const LAS v4u*)(stg + rw * 64 + cc * 8);
                *(v4u*)(pbase + (size_t)(rw & 63) * 4096 + (rw >> 6) * 2048 + cc * 8) = w; }
            LDS_WAIT(); asm volatile("" ::: "memory");
        }
    }
    GRID_BAR();

    REPS(11)
    {
        PHASE_VARS
        pg8::Gemm g{(const bf16*)(P_ws + WS_ADFT), (const bf16*)(P_ws + WS_PQT), 2048, 4096, 1024, 2048, 4096, 0, 0}; pg8::DftOrder S{G, bx};
        pg8::EpiYpart E{(bf16*)(P_outb + OUT_YF)};
        pg8::gemm_phase<pg8::EpiYpart, pg8::DftOrder, true, true>(lds, g, S, E);
        asm volatile("s_waitcnt vmcnt(0)" ::: "memory"); __syncthreads();
        if (tid == 0 && rep_ == 0) __hip_atomic_fetch_add(ctl + CW_F2DONE, 1u, __ATOMIC_RELAXED, __HIP_MEMORY_SCOPE_AGENT);
    }

    REPS(2)
    {
        PHASE_VARS
        const bool nost = (PROBE_DUP == 2 && (PROBE_VAR == 1 || PROBE_VAR == 5) && rep_ == 1), nold = (PROBE_DUP == 2 && PROBE_VAR == 5 && rep_ == 1);
        const int h = bx & 7, nhb = G >> 3, hb = bx >> 3;
        const bf16* Ur = (const bf16*)(P_ws + WS_UR);
        constexpr int WROW = 144;
        LAS unsigned char* WL = lds;
        LAS float* CWL = (LAS float*)(lds + 36864);
        LAS float* PRL = (LAS float*)(lds + 36864 + 2304);
        constexpr int TS = 20, TT = 64 * TS;
        LAS unsigned short* tl = (LAS unsigned short*)(lds + 40960 + wave * 8192);
        {
            const float* const P_rconv_w = TABP(9);
            const float* const P_decay_w0 = TABP(10);
            const float* const P_iclr_a0 = TABP(12);
            const float* const P_k_k = TABP(15);
            const float* const P_k_a = TABP(16);
            const float* const P_r_k = TABP(17);
            const bf16* W2T = (const bf16*)(P_ws + WS_W2T); const bf16* A2T = (const bf16*)(P_ws + WS_A2T);
            for (int i = tid; i < 4 * 64 * 8; i += NWAVES * 64) {
                const int pc = i & 7, ch = (i >> 3) & 63, td = i >> 9, typ = td >> 1, d = td & 1;
                const bf16* srcp = (typ ? A2T : W2T) + ((size_t)(d * CW + h * 64 + ch)) * 64 + pc * 8;
                *(LAS v4u*)(WL + (td * 64 + ch) * WROW + pc * 16) = *(const v4u*)srcp;
            }
            for (int i = tid; i < 9 * 64; i += NWAVES * 64) { const int ch = i & 63, ta = i >> 6, tap = ta / 3, a = ta - tap * 3; CWL[i] = P_rconv_w[tap * 1536 + a * CW + h * 64 + ch]; }
            for (int i = tid; i < 7 * 64; i += NWAVES * 64) { const int ch = i & 63, p = i >> 6;
                const float v = p == 0 ? P_decay_w0[h * 64 + ch] : p == 1 ? P_decay_w0[CW + h * 64 + ch] : p == 2 ? P_iclr_a0[h * 64 + ch] : p == 3 ? P_iclr_a0[CW + h * 64 + ch]
                              : p == 4 ? P_k_k[h * 64 + ch] : p == 5 ? P_k_a[h * 64 + ch] : P_r_k[h * 64 + ch];
                PRL[i] = v; }
        }
        __syncthreads();
        const int ra_wi = hb * NWAVES + wave, ra_W = nhb * NWAVES, ra_RF = (BATCH * 144) / ra_W, ra_LEFT = BATCH * 144 - ra_RF * ra_W; const bool ra_split = 2 * ra_LEFT <= ra_W;
        bool ra_gate_ok = false;
        for (int rk = 0; rk <= ra_RF; ++rk) {
            int bi, dlo, dhi;
            if (rk < ra_RF) { bi = ra_wi + ra_W * rk; dlo = 0; dhi = 2; }
            else if (ra_split) { if (ra_wi >= 2 * ra_LEFT) break; bi = ra_RF * ra_W + (ra_wi >> 1); dlo = ra_wi & 1; dhi = dlo + 1; }
            else { if (ra_wi >= ra_LEFT) break; bi = ra_RF * ra_W + ra_wi; dlo = 0; dhi = 2; }
            int ln = lane; asm volatile("" : "+v"(ln)); ln &= 63;
            const int g = ln >> 4, n = ln & 15, rowD0 = 4 * g;
            const int b = bi / 144, sc = bi - b * 144;
            const bool lat = sc >= 16;
            const int t0 = lat ? (sc - 16) * 16 : sc * 16, T = lat ? SEQ : CTXL, rowbase = lat ? b * SEQ : MLAT + b * CTXL;
            const int t = t0 + n, row = rowbase + t;
            const bf16* ur = nold ? Ur + (size_t)(ln & 15) * 2048 + 4096 : Ur + (size_t)row * 2048;
            const int om = (t > 0) ? -2048 : 0, op = (t < T - 1) ? 2048 : 0; const float m0 = (t > 0) ? 1.f : 0.f, m2 = (t < T - 1) ? 1.f : 0.f;
            v2u cu[3][4][3];
#pragma unroll
            for (int a = 0; a < 3; ++a)
#pragma unroll
                for (int ct = 0; ct < 4; ++ct) { const int col = a * CW + h * 64 + 16 * ct + 4 * g;
                    cu[a][ct][0] = *(const v2u*)(ur + om + col); cu[a][ct][1] = *(const v2u*)(ur + col); cu[a][ct][2] = *(const v2u*)(ur + op + col); }
            v4u wraw[2][2]; pg8::bf16x8 bad[2][2];
#pragma unroll
            for (int d = 0; d < 2; ++d)
#pragma unroll
                for (int ks = 0; ks < 2; ++ks) { wraw[d][ks] = *(const v4u*)(ur + 1536 + d * 64 + 32 * ks + 8 * g); bad[d][ks] = *(const pg8::bf16x8*)(ur + 1664 + d * 64 + 32 * ks + 8 * g); }
            f32x4 accw[2][4], acca[2][4];
#pragma unroll
            for (int d = 0; d < 2; ++d) {
#pragma unroll
                for (int ct = 0; ct < 4; ++ct) { accw[d][ct] = (f32x4){0.f, 0.f, 0.f, 0.f}; acca[d][ct] = (f32x4){0.f, 0.f, 0.f, 0.f}; }
#pragma unroll
                for (int ks = 0; ks < 2; ++ks) {
                    const v4u wr_ = wraw[d][ks]; v4u wt;
                    wt.x = pg8::cvt_pk_bf16(tanh_fast(bflo(wr_.x)), tanh_fast(bfhi(wr_.x))); wt.y = pg8::cvt_pk_bf16(tanh_fast(bflo(wr_.y)), tanh_fast(bfhi(wr_.y)));
                    wt.z = pg8::cvt_pk_bf16(tanh_fast(bflo(wr_.z)), tanh_fast(bfhi(wr_.z))); wt.w = pg8::cvt_pk_bf16(tanh_fast(bflo(wr_.w)), tanh_fast(bfhi(wr_.w)));
                    const pg8::bf16x8 bwd = __builtin_bit_cast(pg8::bf16x8, wt);
#pragma unroll
                    for (int ct = 0; ct < 4; ++ct) {
                        const LAS unsigned char* wp = WL + (d * 64 + 16 * ct + n) * WROW + (32 * ks + 8 * g) * 2;
                        accw[d][ct] = __builtin_amdgcn_mfma_f32_16x16x32_bf16(*(const LAS pg8::bf16x8*)wp, bwd, accw[d][ct], 0, 0, 0);
                        acca[d][ct] = __builtin_amdgcn_mfma_f32_16x16x32_bf16(*(const LAS pg8::bf16x8*)(wp + 128 * WROW), bad[d][ks], acca[d][ct], 0, 0, 0);
                    }
                }
            }
            float Rv[4][4], Kv[4][4], Vv[4][4];
#pragma unroll
            for (int a = 0; a < 3; ++a)
#pragma unroll
                for (int ct = 0; ct < 4; ++ct) {
                    const int cb = a * 64 + 16 * ct + 4 * g;
                    const v2u u0 = cu[a][ct][0], u1 = cu[a][ct][1], u2 = cu[a][ct][2];
                    const f32x4 c0 = *(const LAS f32x4*)(CWL + cb) * m0, c1 = *(const LAS f32x4*)(CWL + 192 + cb), c2 = *(const LAS f32x4*)(CWL + 384 + cb) * m2;
                    const float x0 = c0.x * bflo(u0.x) + c1.x * bflo(u1.x) + c2.x * bflo(u2.x);
                    const float x1 = c0.y * bfhi(u0.x) + c1.y * bfhi(u1.x) + c2.y * bfhi(u2.x);
                    const float x2 = c0.z * bflo(u0.y) + c1.z * bflo(u1.y) + c2.z * bflo(u2.y);
                    const float x3 = c0.w * bfhi(u0.y) + c1.w * bfhi(u1.y) + c2.w * bfhi(u2.y);
                    if (a == 0) { Rv[ct][0] = x0; Rv[ct][1] = x1; Rv[ct][2] = x2; Rv[ct][3] = x3; }
                    else if (a == 1) { Kv[ct][0] = x0; Kv[ct][1] = x1; Kv[ct][2] = x2; Kv[ct][3] = x3; }
                    else { Vv[ct][0] = x0; Vv[ct][1] = x1; Vv[ct][2] = x2; Vv[ct][3] = x3; }
                }
            float KKv[4][4]; float ss = 0.f;
#pragma unroll
            for (int ct = 0; ct < 4; ++ct) { const f32x4 kkp = *(const LAS f32x4*)(PRL + 4 * 64 + 16 * ct + 4 * g);
                KKv[ct][0] = Kv[ct][0] * kkp.x; KKv[ct][1] = Kv[ct][1] * kkp.y; KKv[ct][2] = Kv[ct][2] * kkp.z; KKv[ct][3] = Kv[ct][3] * kkp.w;
#pragma unroll
                for (int e = 0; e < 4; ++e) ss += KKv[ct][e] * KKv[ct][e]; }
            ss += __shfl_xor(ss, 16); ss += __shfl_xor(ss, 32);
            { const float rs = 1.f / sqrtf(ss + 1e-12f);
#pragma unroll
              for (int ct = 0; ct < 4; ++ct)
#pragma unroll
                  for (int e = 0; e < 4; ++e) KKv[ct][e] *= rs; }
#pragma unroll
            for (int ct = 0; ct < 4; ++ct)
#pragma unroll
                for (int e = 0; e < 4; e += 2) { const unsigned vp_ = pg8::cvt_pk_bf16(Vv[ct][e], Vv[ct][e + 1]); tl[2 * TT + (16 * ct + 4 * g + e) * TS + n] = (unsigned short)vp_; tl[2 * TT + (16 * ct + 4 * g + e + 1) * TS + n] = (unsigned short)(vp_ >> 16); }
            LDS_WAIT(); asm volatile("" ::: "memory");
            {
                unsigned char* vd = P_ws + WS_VD + ((size_t)(b * 8 + h) * 144 + sc) * 2048;
#pragma unroll
                for (int it = 0; it < 4; ++it) { const v2u w = *(const LAS v2u*)(tl + 2 * TT + (16 * it + n) * TS + 4 * g); if (!nost && dlo == 0) __builtin_nontemporal_store(w, (v2u*)(vd + it * 512 + ln * 8)); }
            }
            float cpart = 0.f;
#pragma unroll 1
            for (int d = dlo; d < dhi; ++d) {
                unsigned char* rec = recbase(P_ws, P_outb, b) + ((size_t)(h * 2 + d) * 144 + sc) * REC_BYTES;
                f32x4 aw[4], aa[4];
#pragma unroll
                for (int ct = 0; ct < 4; ++ct) {
#pragma unroll
                    for (int e = 0; e < 4; ++e) { aw[ct][e] = d ? accw[1][ct][e] : accw[0][ct][e]; aa[ct][e] = d ? acca[1][ct][e] : acca[0][ct][e]; } }
                pg8::bf16x8 Qf[2], Pf[2], Ktf[2], Btf[2];
#pragma unroll
                for (int m = 0; m < 2; ++m) {
                    float Qv[2][4], Pv[2][4], Ktv[2][4], Btv[2][4];
#pragma unroll
                    for (int cc = 0; cc < 2; ++cc) {
                        const int ct = 2 * m + cc, cb = 16 * ct + 4 * g;
                        const f32x4 w0p = *(const LAS f32x4*)(PRL + d * 64 + cb), a0p = *(const LAS f32x4*)(PRL + (2 + d) * 64 + cb), kap = *(const LAS f32x4*)(PRL + 5 * 64 + cb), rkp = *(const LAS f32x4*)(PRL + 6 * 64 + cb);
                        float GGv[4];
#pragma unroll
                        for (int e = 0; e < 4; ++e) {
                            const float av = sigm_fast(a0p[e] + aa[ct][e]);
                            const float kd = Kv[ct][e] * (1.f + (av - 1.f) * kap[e]), bd = KKv[ct][e] * av;
                            const float lw = -0.875038532f * sigm_fast(w0p[e] + aw[ct][e]);
                            cpart += Rv[ct][e] * kd * rkp[e];
                            float pre = lw; pre += dpp_shr<1>(pre); pre += dpp_shr<2>(pre); pre += dpp_shr<4>(pre); pre += dpp_shr<8>(pre);
                            float tot = lw; tot += dpp_ctl<0xB1>(tot); tot += dpp_ctl<0x4E>(tot); tot += dpp_ctl<0x141>(tot); tot += dpp_ctl<0x140>(tot);
                            const float cs = d ? (tot - pre + lw) : pre;
                            const float E = __builtin_amdgcn_exp2f(cs), Ei = __builtin_amdgcn_exp2f(-cs), Ex = __builtin_amdgcn_exp2f(cs - lw), gg = __builtin_amdgcn_exp2f(tot);
                            Qv[cc][e] = KKv[ct][e] * Ex; Pv[cc][e] = Rv[ct][e] * E; Ktv[cc][e] = kd * Ei; Btv[cc][e] = bd * Ei; GGv[e] = gg;
                            const int ch = 16 * ct + 4 * g + e;
                            { const unsigned kb_ = pg8::cvt_pk_bf16(Ktv[cc][e] * gg, -Btv[cc][e] * gg); tl[ch * TS + n] = (unsigned short)kb_; tl[TT + ch * TS + n] = (unsigned short)(kb_ >> 16); }
                        }
                        if (n == 0) *(LAS f32x4*)((LAS unsigned char*)tl + 7680 + 64 * ct + ln) = (f32x4){GGv[0], GGv[1], GGv[2], GGv[3]};
                        asm volatile("" ::: "memory");
                    }
                    Qf[m] = pack8(Qv[0], Qv[1]); Pf[m] = pack8(Pv[0], Pv[1]); Ktf[m] = pack8(Ktv[0], Ktv[1]); Btf[m] = pack8(Btv[0], Btv[1]);
                }
                if (!ra_gate_ok) {
                    unsigned spins_ = 0; while (__hip_atomic_load(ctl + CW_F2DONE, __ATOMIC_RELAXED, __HIP_MEMORY_SCOPE_AGENT) < (unsigned)G) { __builtin_amdgcn_s_sleep(4); if (++spins_ > (1u << 22)) break; }
                    ra_gate_ok = true; }
                if (!nost) { __builtin_nontemporal_store(Qf[0], (pg8::bf16x8*)(rec + ln * 16)); __builtin_nontemporal_store(Qf[1], (pg8::bf16x8*)(rec + 1024 + ln * 16));
                __builtin_nontemporal_store(Pf[0], (pg8::bf16x8*)(rec + 2048 + ln * 16)); __builtin_nontemporal_store(Pf[1], (pg8::bf16x8*)(rec + 3072 + ln * 16)); }
                const f32x4 z4 = (f32x4){0.f, 0.f, 0.f, 0.f};
                f32x4 AkT = GRAM(Ktf, Qf), Mm = GRAM(Qf, Btf), Mt = GRAM(Btf, Qf), BkT = GRAM(Ktf, Pf), BbT = GRAM(Btf, Pf);
                f32x4 R1;
#pragma unroll
                for (int e = 0; e < 4; ++e) {
                    const int rw = rowD0 + e;
                    const bool rb4c = d ? (rw > n) : (rw < n), cb4r = d ? (n > rw) : (n < rw), eq = (rw == n);
                    AkT[e] = rb4c ? AkT[e] : 0.f; Mm[e] = cb4r ? Mm[e] : 0.f; Mt[e] = rb4c ? Mt[e] : 0.f;
                    BkT[e] = (rb4c || eq) ? BkT[e] : 0.f; BbT[e] = (rb4c || eq) ? BbT[e] : 0.f;
                    R1[e] = (eq ? 1.f : 0.f) - Mt[e];
                }
                const pg8::bf16x8 oM = dop4(Mm), oMt = dop4(Mt);
                const f32x4 M2 = __builtin_amdgcn_mfma_f32_16x16x32_bf16(oMt, oM, z4, 0, 0, 0), Mt2 = __builtin_amdgcn_mfma_f32_16x16x32_bf16(oM, oMt, z4, 0, 0, 0);
                const pg8::bf16x8 oM2 = dop4(M2), oMt2 = dop4(Mt2);
                const f32x4 M4 = __builtin_amdgcn_mfma_f32_16x16x32_bf16(oMt2, oM2, z4, 0, 0, 0), Mt4 = __builtin_amdgcn_mfma_f32_16x16x32_bf16(oM2, oMt2, z4, 0, 0, 0);
                const pg8::bf16x8 oM4 = dop4(M4), oMt4 = dop4(Mt4);
                const f32x4 M8 = __builtin_amdgcn_mfma_f32_16x16x32_bf16(oMt4, oM4, z4, 0, 0, 0);
                const f32x4 R2 = __builtin_amdgcn_mfma_f32_16x16x32_bf16(oM2, dop4(R1), R1, 0, 0, 0);
                const f32x4 R3 = __builtin_amdgcn_mfma_f32_16x16x32_bf16(oM4, dop4(R2), R2, 0, 0, 0);
                const f32x4 Tt = __builtin_amdgcn_mfma_f32_16x16x32_bf16(dop4(M8), dop4(R3), R3, 0, 0, 0);
                { v4u ma; ma.x = pg8::cvt_pk_bf16(AkT[0], AkT[1]); ma.y = pg8::cvt_pk_bf16(AkT[2], AkT[3]); ma.z = pg8::cvt_pk_bf16(Tt[0], Tt[1]); ma.w = pg8::cvt_pk_bf16(Tt[2], Tt[3]);
                  if (!nost) __builtin_nontemporal_store(ma, (v4u*)(rec + 8192 + ln * 16));
                  v4u mb; mb.x = pg8::cvt_pk_bf16(BkT[0], BkT[1]); mb.y = pg8::cvt_pk_bf16(BkT[2], BkT[3]); mb.z = pg8::cvt_pk_bf16(-BbT[0], -BbT[1]); mb.w = pg8::cvt_pk_bf16(-BbT[2], -BbT[3]);
                  if (!nost) __builtin_nontemporal_store(mb, (v4u*)(rec + 9216 + ln * 16)); }
                LDS_WAIT(); asm volatile("" ::: "memory");
#pragma unroll
                for (int jt = 0; jt < 4; ++jt) { const v2u k2 = *(const LAS v2u*)(tl + (16 * jt + n) * TS + 4 * g), b2 = *(const LAS v2u*)(tl + TT + (16 * jt + n) * TS + 4 * g);
                    if (!nost) __builtin_nontemporal_store((v4u){k2.x, k2.y, b2.x, b2.y}, (v4u*)(rec + 4096 + jt * 1024 + ln * 16)); }
                if (ln < 16 && !nost) *(f32x4*)(rec + 10240 + ln * 16) = *(const LAS f32x4*)((const LAS unsigned char*)tl + 7680 + ln * 16);
                LDS_WAIT(); asm volatile("" ::: "memory");
            }
            if (lat) {
                int ln2 = lane; asm volatile("" : "+v"(ln2)); ln2 &= 63;
                const int g2_ = ln2 >> 4, row2 = rowbase + t0 + (ln2 & 15);
                const bf16* ur2 = Ur + (size_t)row2 * 2048;
                cpart += __shfl_xor(cpart, 16); cpart += __shfl_xor(cpart, 32);
                if (g2_ == 0 && !nost) ((float*)(P_outb + (dlo == 0 ? OUT_COEF : OUT_COEF2)))[(size_t)row2 * 8 + h] = cpart;
                if (!nost && dlo == 0) {
                    const v2u sgw = *(const v2u*)(ur2 + 1792 + 16 * h + 4 * g2_);
                    bf16* sg = (bf16*)(P_outb + OUT_SGD) + (size_t)row2 * 128 + 16 * h + 4 * g2_;
                    *(v2u*)sg = (v2u){pg8::cvt_pk_bf16(sigm_fast(bflo(sgw.x)), sigm_fast(bfhi(sgw.x))), pg8::cvt_pk_bf16(sigm_fast(bflo(sgw.y)), sigm_fast(bfhi(sgw.y)))};
                }
            }
        }
    }
    GRID_BAR();

    REPS(3)
    {
        PHASE_VARS
        const bool pvA = (PROBE_DUP == 3 && PROBE_VAR == 2 && rep_ == 1), pvB = (PROBE_DUP == 3 && (PROBE_VAR == 3 || PROBE_VAR == 4) && rep_ == 1), pvC = (PROBE_DUP == 3 && PROBE_VAR == 4 && rep_ == 1);
        if (bx < 2 * BATCH * NH) {
            constexpr int SLOT = 12544, DEPTH = 10;
            const int d = bx >> 6, b = (bx >> 3) & 7, h = bx & 7;
            const unsigned char* rbase = recbase(P_ws, P_outb, b) + ((size_t)(h * 2 + d) * 144) * REC_BYTES;
            const unsigned char* vbase = P_ws + WS_VD + ((size_t)(b * 8 + h) * 144) * 2048;
#define RB_SC(step_) (d == 0 ? (step_) : ((step_) < 16 ? 15 - (step_) : 159 - (step_)))
#define RB_BAR() do { asm volatile("" ::: "memory"); __builtin_amdgcn_s_barrier(); asm volatile("" ::: "memory"); } while (0)
            if (wave >= 4) {
                const int w = wave - 4;
#define RB_ISSUE(step_) do { const int sc_ = RB_SC(step_); LAS unsigned char* sl_ = lds + ((step_) % DEPTH) * SLOT; \
                    const unsigned char* rec_ = rbase + (size_t)sc_ * REC_BYTES; const unsigned char* vd_ = vbase + (size_t)sc_ * 2048; \
                    _Pragma("unroll") for (int q_ = 0; q_ < 3; ++q_) { const int id_ = w + 4 * q_; \
                        const unsigned char* src_ = (id_ < 10) ? rec_ + id_ * 1024 : vd_ + (id_ - 10) * 1024; \
                        LAS unsigned char* dst_ = sl_ + ((id_ < 10) ? id_ * 1024 : 10496 + (id_ - 10) * 1024); \
                        __builtin_amdgcn_global_load_lds((const unsigned*)(src_ + lane * 16), (LAS unsigned*)dst_, 16, 0, 0); } \
                    if (w == 0) __builtin_amdgcn_global_load_lds((const unsigned*)(rec_ + 10240 + lane * 4), (LAS unsigned*)(sl_ + 10240), 4, 0, 0); } while (0)
#define RB_WAIT6() do { if (w == 0) asm volatile("s_waitcnt vmcnt(28)" ::: "memory"); else asm volatile("s_waitcnt vmcnt(21)" ::: "memory"); } while (0)
                if (!pvB) { for (int s = 0; s < DEPTH - 1; ++s) RB_ISSUE(s);
                RB_WAIT6(); }
                RB_BAR();
                for (int s = 0; s < 144; ++s) {
                    if (!pvB) { if (s + DEPTH - 1 < 144) { RB_ISSUE(s + DEPTH - 1); RB_WAIT6(); }
                    else asm volatile("s_waitcnt vmcnt(0)" ::: "memory"); }
                    if (!pvC) RB_BAR();
                }
#undef RB_ISSUE
#undef RB_WAIT6
            } else {
                const int it = wave, g = lane >> 4, c = lane & 15;
                bf16* Yb = (bf16*)(P_ws + (d ? WS_Y1 : WS_Y0));
                f32x4 ST[4];
#pragma unroll
                for (int jt = 0; jt < 4; ++jt) ST[jt] = (f32x4){0.f, 0.f, 0.f, 0.f};
                const f32x4 z4 = (f32x4){0.f, 0.f, 0.f, 0.f};
#define BX8(v) __builtin_bit_cast(pg8::bf16x8, v)
                RB_BAR();
                v4u nQ0, nQ1, nP0, nP1, nK0, nK1, nK2, nK3, nMA, nMB; f32x4 nG0, nG1, nG2, nG3; v2u nV;
#define RB_LDS(step_) do { const LAS unsigned char* sl_ = lds + ((step_) % DEPTH) * SLOT; \
                    nQ0 = *(const LAS v4u*)(sl_ + lane * 16); nQ1 = *(const LAS v4u*)(sl_ + 1024 + lane * 16); nP0 = *(const LAS v4u*)(sl_ + 2048 + lane * 16); nP1 = *(const LAS v4u*)(sl_ + 3072 + lane * 16); \
                    nK0 = *(const LAS v4u*)(sl_ + 4096 + lane * 16); nK1 = *(const LAS v4u*)(sl_ + 5120 + lane * 16); nK2 = *(const LAS v4u*)(sl_ + 6144 + lane * 16); nK3 = *(const LAS v4u*)(sl_ + 7168 + lane * 16); \
                    nMA = *(const LAS v4u*)(sl_ + 8192 + lane * 16); nMB = *(const LAS v4u*)(sl_ + 9216 + lane * 16); \
                    nG0 = *(const LAS f32x4*)(sl_ + 10240 + 16 * g); nG1 = *(const LAS f32x4*)(sl_ + 10240 + 64 + 16 * g); nG2 = *(const LAS f32x4*)(sl_ + 10240 + 128 + 16 * g); nG3 = *(const LAS f32x4*)(sl_ + 10240 + 192 + 16 * g); \
                    nV = *(const LAS v2u*)(sl_ + 10496 + it * 512 + lane * 8); } while (0)
                RB_LDS(0);
                __builtin_amdgcn_s_setprio(3);
                for (int step = 0; step < 144; ++step) {
                    const int sc = RB_SC(step);
                    if (pvA) { RB_BAR(); continue; }
                    const v4u Q0 = nQ0, Q1 = nQ1, P0 = nP0, P1 = nP1, K0 = nK0, K1 = nK1, K2 = nK2, K3 = nK3, MA = nMA, MB = nMB; const f32x4 G0 = nG0, G1 = nG1, G2 = nG2, G3 = nG3; const v2u Vd = nV;
                    if (step + 1 < 144) RB_LDS(step + 1);
                    const v4u bs0 = (v4u){pg8::cvt_pk_bf16(ST[0][0], ST[0][1]), pg8::cvt_pk_bf16(ST[0][2], ST[0][3]), pg8::cvt_pk_bf16(ST[1][0], ST[1][1]), pg8::cvt_pk_bf16(ST[1][2], ST[1][3])};
                    const v4u bs1 = (v4u){pg8::cvt_pk_bf16(ST[2][0], ST[2][1]), pg8::cvt_pk_bf16(ST[2][2], ST[2][3]), pg8::cvt_pk_bf16(ST[3][0], ST[3][1]), pg8::cvt_pk_bf16(ST[3][2], ST[3][3])};
                    f32x4 X = __builtin_amdgcn_mfma_f32_16x16x32_bf16(BX8(Q0), BX8(bs0), z4, 0, 0, 0);
                    X = __builtin_amdgcn_mfma_f32_16x16x32_bf16(BX8(Q1), BX8(bs1), X, 0, 0, 0);
                    X = __builtin_amdgcn_mfma_f32_16x16x32_bf16(BX8(((v4u){MA.x, MA.y, 0u, 0u})), BX8(((v4u){Vd.x, Vd.y, 0u, 0u})), X, 0, 0, 0);
                    const f32x4 U = __builtin_amdgcn_mfma_f32_16x16x32_bf16(BX8(((v4u){MA.z, MA.w, 0u, 0u})), BX8(((v4u){pg8::cvt_pk_bf16(X[0], X[1]), pg8::cvt_pk_bf16(X[2], X[3]), 0u, 0u})), z4, 0, 0, 0);
                    const v4u vu = (v4u){Vd.x, Vd.y, pg8::cvt_pk_bf16(U[0], U[1]), pg8::cvt_pk_bf16(U[2], U[3])};
                    if (sc >= 16) {
                        f32x4 Y = __builtin_amdgcn_mfma_f32_16x16x32_bf16(BX8(P0), BX8(bs0), z4, 0, 0, 0);
                        Y = __builtin_amdgcn_mfma_f32_16x16x32_bf16(BX8(P1), BX8(bs1), Y, 0, 0, 0);
                        Y = __builtin_amdgcn_mfma_f32_16x16x32_bf16(BX8(MB), BX8(vu), Y, 0, 0, 0);
                        bf16* yp = Yb + (size_t)(b * SEQ + (sc - 16) * 16 + 4 * g) * CW + h * 64 + 16 * it + c;
                        if (!pvB) { const unsigned y01 = pg8::cvt_pk_bf16(Y[0], Y[1]), y23 = pg8::cvt_pk_bf16(Y[2], Y[3]); yp[0] = (bf16)y01; yp[CW] = (bf16)(y01 >> 16); yp[2 * CW] = (bf16)y23; yp[3 * CW] = (bf16)(y23 >> 16); } else asm volatile("" :: "v"(Y[0]), "v"(Y[1]), "v"(Y[2]), "v"(Y[3]));
                    }
                    ST[0] = __builtin_amdgcn_mfma_f32_16x16x32_bf16(BX8(K0), BX8(vu), G0 * ST[0], 0, 0, 0);
                    ST[1] = __builtin_amdgcn_mfma_f32_16x16x32_bf16(BX8(K1), BX8(vu), G1 * ST[1], 0, 0, 0);
                    ST[2] = __builtin_amdgcn_mfma_f32_16x16x32_bf16(BX8(K2), BX8(vu), G2 * ST[2], 0, 0, 0);
                    ST[3] = __builtin_amdgcn_mfma_f32_16x16x32_bf16(BX8(K3), BX8(vu), G3 * ST[3], 0, 0, 0);
                    if (!pvC) RB_BAR();
                }
                __builtin_amdgcn_s_setprio(0);
#undef RB_LDS
            }
#undef RB_SC
#undef RB_BAR
        } else {
        {
            const int xw = (bx - 2 * BATCH * NH) * NWAVES + wave, XNW = (G - 2 * BATCH * NH) * NWAVES;
            const int sw_ = bx - 2 * BATCH * NH, nsw_ = G - 2 * BATCH * NH;
            if (nsw_ >= 64) {
                if (sw_ < 64) {
                    const int it = 8 * 32 + sw_ * NWAVES + wave, cb = it >> 5, kc = it & 31, k0 = kc * 32, n0 = cb * 256 + lane * 4;
                    float sb[9];
#pragma unroll
                    for (int b = 0; b < 9; ++b) { const float cv = (b < 8) ? args.in[1][b * D + k0 + (lane & 31)] : args.in[3][k0 + (lane & 31)]; sb[b] = cv / (1.f + __expf(-cv)); }
                    f32x4 acc[9];
#pragma unroll
                    for (int b = 0; b < 9; ++b) acc[b] = (f32x4){0.f, 0.f, 0.f, 0.f};
#pragma unroll
                    for (int kk = 0; kk < 32; ++kk) {
                        const f32x4 wv = *(const f32x4*)(args.in[4] + (size_t)(k0 + kk) * MODW + n0);
#pragma unroll
                        for (int b = 0; b < 9; ++b) { const float s_ = __builtin_bit_cast(float, __builtin_amdgcn_readlane(__builtin_bit_cast(int, sb[b]), kk)); acc[b] += wv * s_; }
                    }
                    LAS float* red = (LAS float*)lds;
#pragma unroll
                    for (int b = 0; b < 9; ++b) *(LAS f32x4*)(red + (wave * 9 + b) * 256 + lane * 4) = acc[b];
                    __syncthreads();
                    for (int q = tid; q < 9 * 64; q += NWAVES * 64) { const int b = q >> 6, c4 = (q & 63) * 4;
                        f32x4 t = *(const LAS f32x4*)(red + b * 256 + c4);
#pragma unroll
                        for (int w = 1; w < 8; ++w) t += *(const LAS f32x4*)(red + (w * 9 + b) * 256 + c4);
                        float* p_ = P_modb + b * MODW + cb * 256 + c4; atomicAdd(p_, t.x); atomicAdd(p_ + 1, t.y); atomicAdd(p_ + 2, t.z); atomicAdd(p_ + 3, t.w); }
                    __syncthreads();
                }
            } else
            for (int it = 8 * 32 + xw; it < 24 * 32; it += XNW) {
                const int cb = it >> 5, kc = it & 31, k0 = kc * 32, n0 = cb * 256 + lane * 4;
                float sb[9];
#pragma unroll
                for (int b = 0; b < 9; ++b) { const float cv = (b < 8) ? args.in[1][b * D + k0 + (lane & 31)] : args.in[3][k0 + (lane & 31)]; sb[b] = cv / (1.f + __expf(-cv)); }
                f32x4 acc[9];
#pragma unroll
                for (int b = 0; b < 9; ++b) acc[b] = (f32x4){0.f, 0.f, 0.f, 0.f};
#pragma unroll
                for (int kk = 0; kk < 32; ++kk) {
                    const f32x4 wv = *(const f32x4*)(args.in[4] + (size_t)(k0 + kk) * MODW + n0);
#pragma unroll
                    for (int b = 0; b < 9; ++b) { const float s = __builtin_bit_cast(float, __builtin_amdgcn_readlane(__builtin_bit_cast(int, sb[b]), kk)); acc[b] += wv * s; }
                }
#pragma unroll
                for (int b = 0; b < 9; ++b) { float* p = P_modb + b * MODW + n0; atomicAdd(p, acc[b].x); atomicAdd(p + 1, acc[b].y); atomicAdd(p + 2, acc[b].z); atomicAdd(p + 3, acc[b].w); }
            }
            LAS float* scr0 = (LAS float*)(lds + wave * 16384);
            bf16* WoutT = (bf16*)(P_ws + WS_WOUT);
            for (int it = xw; it < (D / 64) * (D / 32); it += XNW) transpose_item(args.in[21], D, D, WoutT, 0, scr0, it, lane);
        }
        {
            const float* const P_w_up = TABP(22);
            const float* const P_w_down = TABP(25);
            LAS float* scr = (LAS float*)(lds + wave * 16384);
            bf16* WupT = (bf16*)(P_ws + WS_WUP); bf16* WdnT = (bf16*)(P_ws + WS_WDN);
            constexpr int I_UP = (D / 64) * (F2 / 32), I_DN = (DFF / 64) * (D / 32);
            (void)P_w_down; (void)WdnT; (void)I_DN;
            for (int it = (bx - 2 * BATCH * NH) * NWAVES + wave; it < I_UP; it += (G - 2 * BATCH * NH) * NWAVES) transpose_item(P_w_up, D, F2, WupT, 0, scr, it, lane);
        }
        {
        const float* const P_fourier_g = TABP(20);
        bf16* FN = (bf16*)(P_ws + WS_FN);
        const bf16* Yf = (const bf16*)(P_outb + OUT_YF); const float* ALT = (const float*)(P_ws + WS_ALT);
        for (int row = (bx - 2 * BATCH * NH) * NWAVES + wave; row < MLAT; row += (G - 2 * BATCH * NH) * NWAVES) {
            const int b = row >> 11, k = row & (SEQ - 1), kk = k <= 1024 ? k : 2048 - k;
            float v0, v1, v2, v3, v4, v5, v6, v7;
            if (k == 1024) { const float* ap = ALT + b * 512 + lane * 8; const float s_ = 0.00276213586400995f;
                v0 = ap[0] * s_; v1 = ap[1] * s_; v2 = ap[2] * s_; v3 = ap[3] * s_; v4 = ap[4] * s_; v5 = ap[5] * s_; v6 = ap[6] * s_; v7 = ap[7] * s_; }
            else {
                const bf16* yc = Yf + (size_t)kk * 4096 + b * 512 + lane * 8; const size_t PS = (size_t)2048 * 4096, SS = (size_t)1024 * 4096;
                const v4u c0 = __builtin_nontemporal_load((const v4u*)yc), c1 = __builtin_nontemporal_load((const v4u*)(yc + PS)), s0 = __builtin_nontemporal_load((const v4u*)(yc + SS)), s1 = __builtin_nontemporal_load((const v4u*)(yc + SS + PS));
                const float sg = (k == 0) ? 0.f : (k < 1024 ? -1.f : 1.f);
                v0 = (bflo(c0.x) + bflo(c1.x)) + sg * (bflo(s0.x) + bflo(s1.x)); v1 = (bfhi(c0.x) + bfhi(c1.x)) + sg * (bfhi(s0.x) + bfhi(s1.x));
                v2 = (bflo(c0.y) + bflo(c1.y)) + sg * (bflo(s0.y) + bflo(s1.y)); v3 = (bfhi(c0.y) + bfhi(c1.y)) + sg * (bfhi(s0.y) + bfhi(s1.y));
                v4 = (bflo(c0.z) + bflo(c1.z)) + sg * (bflo(s0.z) + bflo(s1.z)); v5 = (bfhi(c0.z) + bfhi(c1.z)) + sg * (bfhi(s0.z) + bfhi(s1.z));
                v6 = (bflo(c0.w) + bflo(c1.w)) + sg * (bflo(s0.w) + bflo(s1.w)); v7 = (bfhi(c0.w) + bfhi(c1.w)) + sg * (bfhi(s0.w) + bfhi(s1.w));
            }
            const float ss = wave_sum((v0 * v0 + v1 * v1) + (v2 * v2 + v3 * v3) + (v4 * v4 + v5 * v5) + (v6 * v6 + v7 * v7));
            const float rstd = 1.f / sqrtf(ss * (1.f / 512.f) + 1e-6f);
            const f32x4 g0 = *(const f32x4*)(P_fourier_g + lane * 8), g1 = *(const f32x4*)(P_fourier_g + lane * 8 + 4);
            v4u o; o.x = pk2(v0 * rstd * g0.x, v1 * rstd * g0.y); o.y = pk2(v2 * rstd * g0.z, v3 * rstd * g0.w);
            o.z = pk2(v4 * rstd * g1.x, v5 * rstd * g1.y); o.w = pk2(v6 * rstd * g1.z, v7 * rstd * g1.w);
            *(v4u*)(FN + (size_t)row * FW + lane * 8) = o;
        }
        }
        }
    }
    GRID_BAR();

    REPS(4)
    {
        PHASE_VARS
        const float* const P_gn_g = TABP(18);
        const float* const P_gn_b = TABP(19);
        const float* const P_fourier_g = TABP(20);
        const int g = lane >> 4, n = lane & 15, h = wave;
        const bf16* G2T = (const bf16*)(P_ws + WS_G2T); const bf16* SG = (const bf16*)(P_outb + OUT_SGD);
        const bf16* Y0 = (const bf16*)(P_ws + WS_Y0); const bf16* Y1 = (const bf16*)(P_ws + WS_Y1);
        const float* CF = (const float*)(P_outb + OUT_COEF);
        bf16* AR = (bf16*)(P_ws + WS_AR);
        pg8::bf16x8 gw_[4][4];
#pragma unroll
        for (int ks = 0; ks < 4; ++ks)
#pragma unroll
            for (int ct = 0; ct < 4; ++ct) gw_[ks][ct] = *(const pg8::bf16x8*)(G2T + (size_t)(h * 64 + 16 * ct + n) * 128 + 32 * ks + 8 * g);
        pg8::bf16x8 sg_[2][4]; v2u ya_[2][4], yb_[2][4]; float cf_[2]; unsigned vv_[2][16]; int rowS[2]; bool val_[2];
#define R3_MAP(v_) ((G == 256) ? ((bx & 7) * 128 + (bx >> 3) + 32 * ((v_) >> 8)) : (v_))
#define R3_LOAD(s_, cix_, ALWAYS) do { const int cix = (cix_); val_[s_] = cix < BATCH * 128; const int ci = R3_MAP(val_[s_] ? cix : bx); if (ALWAYS || val_[s_]) { \
            const int b = ci >> 7, lc = ci & 127, sc = lc + 16, row = b * SEQ + lc * 16 + n; rowS[s_] = row; \
            _Pragma("unroll") for (int ks = 0; ks < 4; ++ks) sg_[s_][ks] = *(const pg8::bf16x8*)(SG + (size_t)row * 128 + 32 * ks + 8 * g); \
            _Pragma("unroll") for (int ct = 0; ct < 4; ++ct) { const size_t o = (size_t)row * CW + h * 64 + 16 * ct + 4 * g; ya_[s_][ct] = *(const v2u*)(Y0 + o); yb_[s_][ct] = *(const v2u*)(Y1 + o); } \
            cf_[s_] = CF[(size_t)row * 8 + h]; \
            { const int ra_W = (G >> 3) * NWAVES, ra_RF = (BATCH * 144) / ra_W, ra_LEFT = BATCH * 144 - ra_RF * ra_W; if (2 * ra_LEFT <= ra_W && b * 144 + sc >= ra_RF * ra_W) cf_[s_] += ((const float*)(P_outb + OUT_COEF2))[(size_t)row * 8 + h]; } \
            const unsigned short* vd = (const unsigned short*)(P_ws + WS_VD + ((size_t)(b * 8 + h) * 144 + sc) * 2048); \
            _Pragma("unroll") for (int ct = 0; ct < 4; ++ct) _Pragma("unroll") for (int e = 0; e < 4; ++e) vv_[s_][ct * 4 + e] = vd[ct * 256 + (16 * (n >> 2) + 4 * g + e) * 4 + (n & 3)]; } } while (0)
#define R3_COMPUTE(s_) do { const int row = rowS[s_]; \
            f32x4 gt[4]; \
            _Pragma("unroll") for (int ct = 0; ct < 4; ++ct) gt[ct] = (f32x4){0.f, 0.f, 0.f, 0.f}; \
            _Pragma("unroll") for (int ks = 0; ks < 4; ++ks) _Pragma("unroll") for (int ct = 0; ct < 4; ++ct) gt[ct] = __builtin_amdgcn_mfma_f32_16x16x32_bf16(gw_[ks][ct], sg_[s_][ks], gt[ct], 0, 0, 0); \
            f32x4 y[4]; float s = 0.f; \
            _Pragma("unroll") for (int ct = 0; ct < 4; ++ct) { const v2u a_ = ya_[s_][ct], b_ = yb_[s_][ct]; y[ct] = (f32x4){bflo(a_.x) + bflo(b_.x), bfhi(a_.x) + bfhi(b_.x), bflo(a_.y) + bflo(b_.y), bfhi(a_.y) + bfhi(b_.y)}; s += (y[ct].x + y[ct].y) + (y[ct].z + y[ct].w); } \
            s += __shfl_xor(s, 16); s += __shfl_xor(s, 32); \
            const float mu = s * (1.f / 64.f); float q = 0.f; \
            _Pragma("unroll") for (int ct = 0; ct < 4; ++ct) { y[ct] = y[ct] - mu; q += (y[ct].x * y[ct].x + y[ct].y * y[ct].y) + (y[ct].z * y[ct].z + y[ct].w * y[ct].w); } \
            q += __shfl_xor(q, 16); q += __shfl_xor(q, 32); \
            const float rstd = 1.f / sqrtf(q * (1.f / 64.f) + 64e-5f), cf = cf_[s_]; \
            _Pragma("unroll") for (int ct = 0; ct < 4; ++ct) { \
                const int cb = h * 64 + 16 * ct + 4 * g; const f32x4 gg = *(const f32x4*)(P_gn_g + cb), gb = *(const f32x4*)(P_gn_b + cb); \
                float o[4]; \
                _Pragma("unroll") for (int e = 0; e < 4; ++e) { const float vv = bf2f((unsigned short)vv_[s_][ct * 4 + e]); o[e] = (y[ct][e] * rstd * gg[e] + gb[e] + cf * vv) * gt[ct][e]; } \
                if (val_[s_]) *(v2u*)(AR + (size_t)row * CW + cb) = (v2u){pk2(o[0], o[1]), pk2(o[2], o[3])}; } } while (0)
        R3_LOAD(0, bx, true); R3_LOAD(1, bx + G, true);
        for (int ci0 = bx; ci0 < BATCH * 128; ci0 += 2 * G) {
            R3_COMPUTE(0); asm volatile("" ::: "memory"); R3_LOAD(0, ci0 + 2 * G, false);
            R3_COMPUTE(1); asm volatile("" ::: "memory"); R3_LOAD(1, ci0 + 3 * G, false);
        }
    }
#undef R3_LOAD
#undef R3_MAP
#undef R3_COMPUTE
    GRID_BAR();

    REPS(12)
    {
        PHASE_VARS
        const float* const P_x = TABP(0);
        const float* const P_ada_b = TABP(5);
        const float* const P_w_out = TABP(21);
        pg8::Gemm g{(const bf16*)(P_ws + WS_FN), (const bf16*)(P_ws + WS_WOUT), MLAT, D, D, FW, D, 8, (long)WS_AR - (long)WS_FN - 8 * 128};
        pg8::StaticOrder S; S.init(MLAT, D, G, bx);
        const float* const P_norm2_g = TABP(7);
        pg8::RowSumSq st{(unsigned*)(P_ws + WS_XBUF), ctl + CW_SEAM};
        pg8::EpiResNormMod E{P_x, P_outp, (bf16*)(P_ws + WS_H2), P_modb, P_ada_b, P_norm2_g, 2 * D, 3 * D, 4 * D, st};
        pg8::gemm_phase<pg8::EpiResNormMod, pg8::StaticOrder, false, true>(lds, g, S, E);
    }
    GRID_BAR();

    for (int half = 0; half < 2; ++half) {
        const float* const P_w_up = TABP(22);
        const float* const P_fconv_w = TABP(23);
        const float* const P_fconv_b = TABP(24);
        REPS(13)
        {
            PHASE_VARS
            pg8::Gemm g{(const bf16*)(P_ws + WS_H2) + (size_t)half * 8192 * D, (const bf16*)(P_ws + WS_WUP), 8192, F2, D, D, D, 0, 0}; pg8::StaticOrder S; S.init(8192, F2, G, bx);
            pg8::EpiBf16 E{(bf16*)(P_ws + WS_U2), F2, PROBE_DUP == 13 && PROBE_VAR == 1 && rep_ == 1, ctl + CW_P7DONE, half == 1 ? (unsigned)G : 0u};
            pg8::gemm_phase<pg8::EpiBf16, pg8::StaticOrder, true, true>(lds, g, S, E);
            if (half == 0 && rep_ == 0) {
                const float* const P_w_down = TABP(25);
                const int nwg_ = (8192 / pg8::BM) * (F2 / pg8::BM), most_ = (nwg_ + G - 1) / G, n_full = nwg_ - (most_ - 1) * G, n_idle = G - n_full;
                const int first_ = n_idle > 0 ? n_full : 0, cnt_ = n_idle > 0 ? n_idle : G;
                if (bx >= first_) {
                    LAS float* scr = (LAS float*)(lds + wave * 16384); bf16* WdnT = (bf16*)(P_ws + WS_WDN);
                    for (int it = (bx - first_) * NWAVES + wave; it < (DFF / 64) * (D / 32); it += cnt_ * NWAVES) transpose_item(P_w_down, DFF, D, WdnT, 0, scr, it, lane);
                }
            }
        }
        GRID_BAR();
        REPS(5)
        {
            PHASE_VARS
            const float* const P_fconv_w = TABP(23);
            const float* const P_fconv_b = TABP(24);
            const bf16* U2 = (const bf16*)(P_ws + WS_U2); bf16* ACT = (bf16*)(P_ws + WS_ACT) + (size_t)half * 8192 * DFF;
            const int xcd = bx & 7, widx = (bx >> 3) * NWAVES + wave, nwx = (G >> 3) * NWAVES;
            for (int j = widx; j < 704; j += nwx) {
                int ln = lane; asm volatile("" : "+v"(ln));
                const int jj = 704 * xcd + j, comb = jj >> 7, r1 = jj & 127, seg = r1 & 7, gp = r1 >> 3, bl = comb / 11, fg = comb - bl * 11;
                const int f = fg * 256 + ln * 4, gc0 = seg * 8, gr = gp * 2;
                f32x4 wg[9], wv[9];
#pragma unroll
                for (int k = 0; k < 9; ++k) { wg[k] = *(const f32x4*)(P_fconv_w + (size_t)k * F2 + f); wv[k] = *(const f32x4*)(P_fconv_w + (size_t)k * F2 + DFF + f); }
                const f32x4 bg = *(const f32x4*)(P_fconv_b + f), bv = *(const f32x4*)(P_fconv_b + DFF + f);
                const int ra = gr > 0 ? gr - 1 : gr, rd = gr + 2 < 32 ? gr + 2 : gr + 1; const unsigned mra = gr > 0 ? 0xffffffffu : 0u, mrd = gr + 2 < 32 ? 0xffffffffu : 0u;
                const bf16* ub = U2 + (size_t)(bl * SEQ) * F2 + f;
                v2u cg[3][4], cv[3][4];
#define P7_LOADCOL(slot, gc) do { const int gcc = (gc) < 0 ? 0 : ((gc) > 63 ? 63 : (gc)); const unsigned mc = ((gc) < 0 || (gc) > 63) ? 0u : 0xffffffffu; \
                    const bf16* pa = ub + (size_t)(ra * 64 + gcc) * F2; const bf16* pb = ub + (size_t)(gr * 64 + gcc) * F2; const bf16* pc = pb + (size_t)64 * F2; const bf16* pd = ub + (size_t)(rd * 64 + gcc) * F2; \
                    v2u a0 = *(const v2u*)pa, a1 = *(const v2u*)pb, a2 = *(const v2u*)pc, a3 = *(const v2u*)pd, d0 = *(const v2u*)(pa + DFF), d1 = *(const v2u*)(pb + DFF), d2 = *(const v2u*)(pc + DFF), d3 = *(const v2u*)(pd + DFF); \
                    const unsigned ma_ = mc & mra, md_ = mc & mrd; \
                    cg[slot][0] = (v2u){a0.x & ma_, a0.y & ma_}; cg[slot][1] = (v2u){a1.x & mc, a1.y & mc}; cg[slot][2] = (v2u){a2.x & mc, a2.y & mc}; cg[slot][3] = (v2u){a3.x & md_, a3.y & md_}; \
                    cv[slot][0] = (v2u){d0.x & ma_, d0.y & ma_}; cv[slot][1] = (v2u){d1.x & mc, d1.y & mc}; cv[slot][2] = (v2u){d2.x & mc, d2.y & mc}; cv[slot][3] = (v2u){d3.x & md_, d3.y & md_}; } while (0)
                P7_LOADCOL(0, gc0 - 1); P7_LOADCOL(1, gc0);
#pragma unroll
                for (int j = 0; j < 8; ++j) {
                    P7_LOADCOL((j + 2) % 3, gc0 + j + 1);
#pragma unroll
                    for (int orow = 0; orow < 2; ++orow) {
                        f32x4 ga = bg, va = bv;
#pragma unroll
                        for (int dc = 0; dc < 3; ++dc) { const int sl = (j + dc) % 3;
#pragma unroll
                            for (int dr = 0; dr < 3; ++dr) { const v2u xg = cg[sl][orow + dr], xv = cv[sl][orow + dr]; const int k = dr * 3 + dc;
                                ga += wg[k] * (f32x4){bflo(xg.x), bfhi(xg.x), bflo(xg.y), bfhi(xg.y)};
                                va += wv[k] * (f32x4){bflo(xv.x), bfhi(xv.x), bflo(xv.y), bfhi(xv.y)}; } }
                        float r[4];
#pragma unroll
                        for (int q = 0; q < 4; ++q) r[q] = ga[q] * sigm_fast(ga[q]) * va[q];
                        *(v2u*)(ACT + (size_t)(bl * SEQ + (gr + orow) * 64 + gc0 + j) * DFF + f) = (v2u){pg8::cvt_pk_bf16(r[0], r[1]), pg8::cvt_pk_bf16(r[2], r[3])};
                    }
                }
#undef P7_LOADCOL
            }
            if (half == 0 && rep_ == 0) {
                asm volatile("s_waitcnt vmcnt(0)" ::: "memory"); __syncthreads();
                if (tid == 0) __hip_atomic_fetch_add(ctl + CW_P7DONE, 1u, __ATOMIC_RELAXED, __HIP_MEMORY_SCOPE_AGENT);
            }
        }
        if (half == 1) GRID_BAR();
    }

    {
        PHASE_VARS
        const float* const P_ada_b = TABP(5);
        const float* const P_w_down = TABP(25);
        pg8::Gemm g{(const bf16*)(P_ws + WS_ACT), (const bf16*)(P_ws + WS_WDN), MLAT, D, DFF, DFF, DFF, 0, 0}; pg8::StaticOrder S; S.init(MLAT, D, G, bx);
        const float* const P_final_g = TABP(26);
        pg8::RowSumSq st{(unsigned*)(P_ws + WS_XBUF + 262144), ctl + CW_SEAM + SEAM_BANK};
        pg8::EpiResNorm E{P_outp, P_outp, P_modb, P_ada_b, P_final_g, 5 * D, st};
        pg8::gemm_phase<pg8::EpiResNorm, pg8::StaticOrder, false, true>(lds, g, S, E);
    }

}

extern "C" void kernel_launch(void* const* d_in, const int* in_sizes, int n_in, void* d_out, int out_size, void* d_ws, size_t ws_size, hipStream_t stream) {
    static int grid = 0;
    if (grid == 0) {
        if (n_in != 27 || out_size != MLAT * D || ws_size < WS_END) { fprintf(stderr, "kernel_launch: unexpected sizes n_in %d out %d ws %zu\n", n_in, out_size, ws_size); grid = -1; return; }
        int dev = 0, cus = 0, per_cu = 0;
        if (hipGetDevice(&dev) != hipSuccess || hipDeviceGetAttribute(&cus, hipDeviceAttributeMultiprocessorCount, dev) != hipSuccess) { grid = -1; return; }
        if (hipFuncSetAttribute((const void*)fwd_kernel, hipFuncAttributeMaxDynamicSharedMemorySize, LDS_BYTES) != hipSuccess) { fprintf(stderr, "kernel_launch: hipFuncSetAttribute failed\n"); grid = -1; return; }
        if (hipOccupancyMaxActiveBlocksPerMultiprocessor(&per_cu, (const void*)fwd_kernel, NWAVES * 64, LDS_BYTES) != hipSuccess || per_cu < 1) { fprintf(stderr, "kernel_launch: occupancy query says %d\n", per_cu); }
        (void)hipGetLastError();
        grid = cus;
    }
    if (grid < 0) return;
    if (hipMemsetAsync((char*)d_ws + WS_CTL, 0, CTL_ZERO_BYTES, stream) != hipSuccess) { fprintf(stderr, "kernel_launch: memset failed\n"); return; }
    Args a{};
    for (int i = 0; i < 27; ++i) a.in[i] = (const float*)d_in[i];
    a.out = (float*)d_out; a.ws = (unsigned char*)d_ws;
    void* kargs[] = {&a};
    hipError_t e = hipLaunchCooperativeKernel((const void*)fwd_kernel, dim3(grid), dim3(NWAVES * 64), kargs, LDS_BYTES, stream);
    if (e != hipSuccess) fprintf(stderr, "kernel_launch: cooperative launch failed: %s (grid %d)\n", hipGetErrorString(e), grid);
}
```
